# Optimizing an MI355X kernel written in HIP

```python
import jax, jax.numpy as jnp
from jax import lax
import numpy as np


D_MODEL = 1024
BATCH = 8
SEQ = 4096
DEPTH = 2

D_FF = 2816
FFN_RES_SCALE = 0.5
RMS_EPS = 1e-6
PLE_DIM = 256
QBLK = 128
A_HEADS = 8
A_KV_HEADS = 2
A_GROUP = A_HEADS // A_KV_HEADS
A_HEAD_DIM = 64
WINDOW = 128
B_HEADS = 8
B_Q_LORA = 256
B_KV_LORA = 128
B_NOPE_DIM = 64
B_ROPE_DIM = 32
B_V_DIM = 64
ROPE_THETA = 10000.0
C_HEADS = 16
C_HEAD_DIM = 64
FORGET_BIAS_CENTER = 3.0
N_EVEN = (DEPTH + 1) // 2
N_ODD = DEPTH // 2
EVEN_IN_SPLITS = (A_HEADS * A_HEAD_DIM, A_KV_HEADS * A_HEAD_DIM, A_KV_HEADS * A_HEAD_DIM, B_Q_LORA, B_KV_LORA, B_ROPE_DIM)
EVEN_IN_DIM = A_HEADS * A_HEAD_DIM + 2 * A_KV_HEADS * A_HEAD_DIM + B_Q_LORA + B_KV_LORA + B_ROPE_DIM
EVEN_MIX_DIM = A_HEADS * A_HEAD_DIM + B_HEADS * B_V_DIM
ODD_MIX_DIM = C_HEADS * C_HEAD_DIM
ODD_IN_DIM = 3 * ODD_MIX_DIM + C_HEADS

kernel_name = 'hybrid_swa_mla_fox_macaron'


def rms_norm(x, g):
    xf = x.astype(jnp.float32)
    y = xf * lax.rsqrt(jnp.mean(xf * xf, axis=-1, keepdims=True) + RMS_EPS)
    return (y * g.astype(jnp.float32)).astype(x.dtype)


def swiglu(x, w_gate_up, w_down):
    g, u = jnp.split(x @ w_gate_up, 2, axis=-1)
    return (jax.nn.silu(g) * u) @ w_down


def alibi_slopes(n):
    return 2.0 ** (-8.0 * jnp.arange(1, n + 1, dtype=jnp.float32) / n)


def rope_tables(seq, dim):
    inv = ROPE_THETA ** (-jnp.arange(0, dim, 2, dtype=jnp.float32) / dim)
    ang = jnp.arange(seq, dtype=jnp.float32)[:, None] * inv[None, :]
    return jnp.cos(ang), jnp.sin(ang)


def apply_rope(x, cos, sin):
    half = x.shape[-1] // 2
    x1 = x[..., :half].astype(jnp.float32)
    x2 = x[..., half:].astype(jnp.float32)
    return jnp.concatenate([x1 * cos - x2 * sin, x1 * sin + x2 * cos], axis=-1).astype(x.dtype)


def swa_sink_attention(q, k, v, sinks):
    B, S = q.shape[0], q.shape[1]
    nb = S // WINDOW
    qb = q.reshape(B, nb, WINDOW, A_KV_HEADS, A_GROUP, A_HEAD_DIM)
    pad = jnp.zeros((B, WINDOW, A_KV_HEADS, A_HEAD_DIM), k.dtype)
    kp = jnp.concatenate([pad, k], axis=1).reshape(B, nb + 1, WINDOW, A_KV_HEADS, A_HEAD_DIM)
    vp = jnp.concatenate([pad, v], axis=1).reshape(B, nb + 1, WINDOW, A_KV_HEADS, A_HEAD_DIM)
    kb = jnp.concatenate([kp[:, :-1], kp[:, 1:]], axis=2)
    vb = jnp.concatenate([vp[:, :-1], vp[:, 1:]], axis=2)
    s = jnp.einsum('bnqkgd,bnskd->bnkgqs', qb, kb).astype(jnp.float32) * (A_HEAD_DIM ** -0.5)
    qi = jnp.arange(WINDOW)[:, None]
    kj = jnp.arange(2 * WINDOW)[None, :]
    dist = qi + WINDOW - kj
    band = (dist >= 0) & (dist < WINDOW)
    start_ok = (jnp.arange(nb)[:, None, None] * WINDOW + kj[None] - WINDOW) >= 0
    mask = band[None] & start_ok
    slopes = alibi_slopes(A_HEADS).reshape(A_KV_HEADS, A_GROUP)
    s = s - slopes[None, None, :, :, None, None] * dist.astype(jnp.float32)[None, None, None, None]
    s = jnp.where(mask[None, :, None, None], s, -jnp.inf)
    sink = sinks.astype(jnp.float32).reshape(A_KV_HEADS, A_GROUP)[None, None, :, :, None, None]
    m = jnp.maximum(jnp.max(s, axis=-1, keepdims=True), sink)
    e = jnp.exp(s - m)
    pr = e / (jnp.sum(e, axis=-1, keepdims=True) + jnp.exp(sink - m))
    out = jnp.einsum('bnkgqs,bnskd->bnqkgd', pr.astype(v.dtype), vb)
    return out.reshape(B, S, A_HEADS * A_HEAD_DIM)


def mla_attention(q_nope, q_rope, k_nope, k_rope, v):
    B, S = q_nope.shape[0], q_nope.shape[1]
    nb = S // QBLK
    qn = q_nope.reshape(B, nb, QBLK, B_HEADS, B_NOPE_DIM).transpose(1, 0, 2, 3, 4)
    qr = q_rope.reshape(B, nb, QBLK, B_HEADS, B_ROPE_DIM).transpose(1, 0, 2, 3, 4)
    kpos = jnp.arange(S)
    scale = (B_NOPE_DIM + B_ROPE_DIM) ** -0.5

    def one_block(args):
        qn_b, qr_b, n = args
        s = jnp.einsum('bqhd,bkhd->bhqk', qn_b, k_nope) + jnp.einsum('bqhd,bkd->bhqk', qr_b, k_rope)
        s = s.astype(jnp.float32) * scale
        qpos = n * QBLK + jnp.arange(QBLK)
        s = jnp.where(kpos[None, :] <= qpos[:, None], s, -jnp.inf)
        pr = jax.nn.softmax(s, axis=-1)
        return jnp.einsum('bhqk,bkhd->bqhd', pr.astype(v.dtype), v)

    out = lax.map(one_block, (qn, qr, jnp.arange(nb)))
    return out.transpose(1, 0, 2, 3, 4).reshape(B, S, B_HEADS * B_V_DIM)


def fox_attention(q, k, v, logc):
    B, S = q.shape[0], q.shape[1]
    nb = S // QBLK
    qb = q.reshape(B, nb, QBLK, C_HEADS, C_HEAD_DIM).transpose(1, 0, 2, 3, 4)
    cb = logc.reshape(B, nb, QBLK, C_HEADS).transpose(1, 0, 2, 3)
    c_keys = logc.transpose(0, 2, 1)
    kpos = jnp.arange(S)

    def one_block(args):
        q_b, c_b, n = args
        s = jnp.einsum('bqhd,bkhd->bhqk', q_b, k).astype(jnp.float32) * (C_HEAD_DIM ** -0.5)
        s = s + c_b.transpose(0, 2, 1)[..., None] - c_keys[:, :, None, :]
        qpos = n * QBLK + jnp.arange(QBLK)
        s = jnp.where(kpos[None, :] <= qpos[:, None], s, -jnp.inf)
        pr = jax.nn.softmax(s, axis=-1)
        return jnp.einsum('bhqk,bkhd->bqhd', pr.astype(v.dtype), v)

    out = lax.map(one_block, (qb, cb, jnp.arange(nb)))
    return out.transpose(1, 0, 2, 3, 4).reshape(B, S, C_HEADS * C_HEAD_DIM)


def even_mixer(h, w_in, sinks, cq_norm, w_uq, ckv_norm, w_ukv, w_out):
    B, S = h.shape[0], h.shape[1]
    idx = [int(i) for i in np.cumsum(EVEN_IN_SPLITS)[:-1]]
    a_q, a_k, a_v, c_q, c_kv, k_rope = jnp.split(h @ w_in, idx, axis=-1)
    out_a = swa_sink_attention(a_q.reshape(B, S, A_HEADS, A_HEAD_DIM),
                               a_k.reshape(B, S, A_KV_HEADS, A_HEAD_DIM),
                               a_v.reshape(B, S, A_KV_HEADS, A_HEAD_DIM), sinks)
    q = (rms_norm(c_q, cq_norm) @ w_uq).reshape(B, S, B_HEADS, B_NOPE_DIM + B_ROPE_DIM)
    kv = (rms_norm(c_kv, ckv_norm) @ w_ukv).reshape(B, S, B_HEADS, B_NOPE_DIM + B_V_DIM)
    cos, sin = rope_tables(S, B_ROPE_DIM)
    q_nope = q[..., :B_NOPE_DIM]
    q_rope = apply_rope(q[..., B_NOPE_DIM:], cos[None, :, None], sin[None, :, None])
    k_nope = kv[..., :B_NOPE_DIM]
    v = kv[..., B_NOPE_DIM:]
    k_rope = apply_rope(k_rope, cos[None], sin[None])
    out_b = mla_attention(q_nope, q_rope, k_nope, k_rope, v)
    return jnp.concatenate([out_a, out_b], axis=-1) @ w_out


def odd_mixer(h, w_in, b_f, w_out):
    B, S = h.shape[0], h.shape[1]
    w = ODD_MIX_DIM
    q, k, v, f_logit = jnp.split(h @ w_in, [w, 2 * w, 3 * w], axis=-1)
    logf = jax.nn.log_sigmoid(f_logit.astype(jnp.float32) + b_f.astype(jnp.float32))
    logc = jnp.cumsum(logf, axis=1)
    shp = (B, S, C_HEADS, C_HEAD_DIM)
    out = fox_attention(q.reshape(shp), k.reshape(shp), v.reshape(shp), logc)
    return out @ w_out


def _normal(key, shape, scale):
    return jax.random.normal(key, shape, jnp.float32) * scale


def setup_inputs(seed: int = 0) -> dict:
    key = jax.random.key(seed)
    ks = jax.random.split(key, 23)
    D = D_MODEL
    return {
        'x': _normal(ks[0], (BATCH, SEQ, D), 1.0),
        'p': _normal(ks[1], (DEPTH, BATCH, SEQ, PLE_DIM), 1.0),
        'ffa_norm': 1.0 + _normal(ks[2], (DEPTH, D), 0.05),
        'ffa_w_gate_up': _normal(ks[3], (DEPTH, D, 2 * D_FF), D ** -0.5),
        'ffa_w_down': _normal(ks[4], (DEPTH, D_FF, D), D_FF ** -0.5),
        'mix_norm': 1.0 + _normal(ks[5], (DEPTH, D), 0.05),
        'ffb_norm': 1.0 + _normal(ks[6], (DEPTH, D), 0.05),
        'ffb_w_gate_up': _normal(ks[7], (DEPTH, D, 2 * D_FF), D ** -0.5),
        'ffb_w_down': _normal(ks[8], (DEPTH, D_FF, D), D_FF ** -0.5),
        'ple_norm': 1.0 + _normal(ks[9], (DEPTH, D), 0.05),
        'ple_w_gate': _normal(ks[10], (DEPTH, D, D), D ** -0.5),
        'ple_w_proj': _normal(ks[11], (DEPTH, PLE_DIM, D), PLE_DIM ** -0.5),
        'ev_w_in': _normal(ks[12], (N_EVEN, D, EVEN_IN_DIM), D ** -0.5),
        'ev_sinks': _normal(ks[13], (N_EVEN, A_HEADS), 0.5),
        'ev_cq_norm': 1.0 + _normal(ks[14], (N_EVEN, B_Q_LORA), 0.05),
        'ev_w_uq': _normal(ks[15], (N_EVEN, B_Q_LORA, B_HEADS * (B_NOPE_DIM + B_ROPE_DIM)), B_Q_LORA ** -0.5),
        'ev_ckv_norm': 1.0 + _normal(ks[16], (N_EVEN, B_KV_LORA), 0.05),
        'ev_w_ukv': _normal(ks[17], (N_EVEN, B_KV_LORA, B_HEADS * (B_NOPE_DIM + B_V_DIM)), B_KV_LORA ** -0.5),
        'ev_w_out': _normal(ks[18], (N_EVEN, EVEN_MIX_DIM, D), EVEN_MIX_DIM ** -0.5),
        'od_w_in': _normal(ks[19], (N_ODD, D, ODD_IN_DIM), D ** -0.5),
        'od_b_f': FORGET_BIAS_CENTER + _normal(ks[20], (N_ODD, C_HEADS), 0.5),
        'od_w_out': _normal(ks[21], (N_ODD, ODD_MIX_DIM, D), ODD_MIX_DIM ** -0.5),
        'final_norm': 1.0 + _normal(ks[22], (D,), 0.05),
    }


def reference(x, p, ffa_norm, ffa_w_gate_up, ffa_w_down, mix_norm, ffb_norm, ffb_w_gate_up, ffb_w_down,
              ple_norm, ple_w_gate, ple_w_proj, ev_w_in, ev_sinks, ev_cq_norm, ev_w_uq, ev_ckv_norm,
              ev_w_ukv, ev_w_out, od_w_in, od_b_f, od_w_out, final_norm):
    h = x
    for i in range(DEPTH):
        j = i // 2
        h = h + FFN_RES_SCALE * swiglu(rms_norm(h, ffa_norm[i]), ffa_w_gate_up[i], ffa_w_down[i])
        hn = rms_norm(h, mix_norm[i])
        if i % 2 == 0:
            h = h + even_mixer(hn, ev_w_in[j], ev_sinks[j], ev_cq_norm[j], ev_w_uq[j],
                               ev_ckv_norm[j], ev_w_ukv[j], ev_w_out[j])
        else:
            h = h + odd_mixer(hn, od_w_in[j], od_b_f[j], od_w_out[j])
        h = h + FFN_RES_SCALE * swiglu(rms_norm(h, ffb_norm[i]), ffb_w_gate_up[i], ffb_w_down[i])
        gate = jax.nn.sigmoid(rms_norm(h, ple_norm[i]) @ ple_w_gate[i])
        h = h + gate * (p[i] @ ple_w_proj[i])
    return rms_norm(h, final_norm)
```

```cpp
#include <hip/hip_runtime.h>
#include <hip/hip_cooperative_groups.h>
#include <stdint.h>
#include <stdio.h>
namespace cg = cooperative_groups;

__device__ __forceinline__ int tid_fresh() { int t = threadIdx.x; asm volatile("" : "+v"(t)); return t; }
namespace pg8 {
#define PG8_LAS __attribute__((address_space(3)))
typedef unsigned short bf16_t;
typedef short bf16x8 __attribute__((ext_vector_type(8)));
typedef float f32x4 __attribute__((ext_vector_type(4)));
typedef unsigned u32x4 __attribute__((ext_vector_type(4)));
constexpr int BM = 256, BK = 64, HALF = 128, HTB = HALF * BK * 2  , STAGE_BYTES = 8 * HTB, NXCD = 8, WGM = 8;

__host__ __device__ __forceinline__ int lds_byte(int r, int c) { const int st = (r >> 4) * 2 + (c >> 5), rr = r & 15, cc = c & 31, ob = rr * 64 + cc * 2; return st * 1024 + (ob ^ (((ob >> 9) & 1) << 5)); }
__host__ __device__ __forceinline__ void stage_rc(int b, int& R, int& C) { const int st = b / 1024, sb = b % 1024, swz = sb ^ (((sb >> 9) & 1) << 5); R = (st >> 1) * 16 + swz / 64; C = (st & 1) * 32 + (swz % 64) / 2; }
__host__ __device__ __forceinline__ int perm32(int rho) { const int n = rho >> 4, i = rho & 15; return 8 * (i >> 2) + 4 * n + (i & 3); }

struct Unit { int pm, pn; };
struct Gemm { const bf16_t* A; const bf16_t* Bt; int M, N, K; };

struct StaticOrder {
    int nM, nN, nwg, G, c;
    __host__ __device__ void init(int M, int N, int G_, int c_) { nM = M / BM; nN = N / BM; nwg = nM * nN; G = G_; c = c_; }
    __host__ __device__ bool next(int i, Unit& u) const {
        const long L = (long)i * G + c; if (L >= nwg) return false;
        int wgid = (int)L; { const int q = nwg / NXCD, r = nwg % NXCD, xcd = wgid % NXCD, off = wgid / NXCD; wgid = (xcd < r ? xcd * (q + 1) : r * (q + 1) + (xcd - r) * q) + off; }
        const int nig = WGM * nN, gid = wgid / nig, fm = gid * WGM, gsz = (nM - fm) < WGM ? (nM - fm) : WGM;
        u.pm = fm + ((wgid % nig) % gsz); u.pn = (wgid % nig) / gsz; return true;
    }
    __device__ __forceinline__ void a_ready(const Unit&) const {}
    __device__ __forceinline__ void done(const Unit&) const {}
};
template <class Epi, class Sched, bool ALIGN_EPI = false, bool SP2 = false>
__device__ __forceinline__ void gemm_phase(PG8_LAS unsigned char* lds, const Gemm g, const Sched& S, const Epi& E) {
    const int tid = tid_fresh(), wid = __builtin_amdgcn_readfirstlane(tid >> 6), lane = tid & 63, wr = wid >> 2, wc = wid & 3, fr = lane & 15, fq = lane >> 4;
    const int K = g.K, nt = K / BK;
    unsigned voffA[2], voffB[2];
#pragma unroll
    for (int i = 0; i < 2; ++i) { int R, C; stage_rc(tid * 16 + i * 8192, R, C); const int Rb = Epi::PERM ? ((R & ~31) + perm32(R & 31)) : R;
        voffA[i] = (unsigned)(R * K + C) * 2u; voffB[i] = (unsigned)(Rb * K + C) * 2u; }
    const size_t kstep = (size_t)(BK * 2);
    const size_t hstep = (size_t)HALF * K * 2;
    const size_t tstep = 2 * hstep;
    const unsigned ldsw = (unsigned)wid * 1024u;
    const int aoff = lds_byte(wr * 64 + fr, fq * 8), boff = lds_byte(wc * 32 + fr, fq * 8);
#define PG8_SA(b, h) (((b) * 2 + (h)) * HTB)
#define PG8_SB(b, h) ((4 + (b) * 2 + (h)) * HTB)
#define PG8_STAGE(bufoff, gbase, voff) do { _Pragma("unroll") for (int _i = 0; _i < 2; ++_i) \
        __builtin_amdgcn_global_load_lds((const unsigned*)((const char*)(gbase) + (voff)[_i]), (PG8_LAS unsigned*)(lds + (bufoff) + ldsw + _i * 8192), 16, 0, 0); } while (0)
#define PG8_LDA(dst, b, h) do { _Pragma("unroll") for (int m = 0; m < 4; ++m) _Pragma("unroll") for (int k = 0; k < 2; ++k) dst[m][k] = *(const PG8_LAS bf16x8*)(lds + PG8_SA(b, h) + aoff + m * 2048 + k * 1024); } while (0)
#define PG8_LDB(dst, b, h) do { _Pragma("unroll") for (int n = 0; n < 2; ++n) _Pragma("unroll") for (int k = 0; k < 2; ++k) dst[n][k] = *(const PG8_LAS bf16x8*)(lds + PG8_SB(b, h) + boff + n * 2048 + k * 1024); } while (0)
#define PG8_MMA(ai, bj, At, Bt) do { __builtin_amdgcn_s_setprio(1); _Pragma("unroll") for (int m = 0; m < 4; ++m) _Pragma("unroll") for (int n = 0; n < 2; ++n) _Pragma("unroll") for (int k = 0; k < 2; ++k) \
        acc[ai][bj][m][n] = __builtin_amdgcn_mfma_f32_16x16x32_bf16(Bt[n][k], At[m][k], acc[ai][bj][m][n], 0, 0, 0); __builtin_amdgcn_s_setprio(0); } while (0)
#define PG8_WAIT_V(n) asm volatile("s_waitcnt vmcnt(" #n ")" ::: "memory")
#define PG8_WAIT_L(n) asm volatile("s_waitcnt lgkmcnt(" #n ")" ::: "memory")
#define PG8_BAR __builtin_amdgcn_s_barrier()
#define PG8_SCHED __builtin_amdgcn_sched_barrier(0)
    Unit cur, nxt; int ui = 0;
    if (!S.next(0, cur)) return;
    f32x4 acc[2][2][4][2];
#pragma unroll
    for (int a = 0; a < 2; ++a)
#pragma unroll
        for (int b = 0; b < 2; ++b)
#pragma unroll
            for (int m = 0; m < 4; ++m)
#pragma unroll
                for (int n = 0; n < 2; ++n) acc[a][b][m][n] = (f32x4){0.f, 0.f, 0.f, 0.f};
    bf16x8 At[4][2], B0[2][2], B1[2][2];
    const char* cA = (const char*)g.A + (size_t)cur.pm * tstep; const char* cB = (const char*)g.Bt + (size_t)cur.pn * tstep;
    S.a_ready(cur);
    if constexpr (SP2) {
        PG8_STAGE(PG8_SB(0, 0), cB, voffB); PG8_STAGE(PG8_SB(0, 1), cB + hstep, voffB); PG8_STAGE(PG8_SA(0, 0), cA, voffA); PG8_STAGE(PG8_SA(0, 1), cA + hstep, voffA);
        if (wr == 1) PG8_BAR;
        PG8_WAIT_V(2); PG8_BAR;
        PG8_STAGE(PG8_SB(1, 0), cB + kstep, voffB); PG8_STAGE(PG8_SA(1, 0), cA + kstep, voffA); PG8_STAGE(PG8_SB(1, 1), cB + hstep + kstep, voffB);
        PG8_WAIT_V(6); PG8_BAR;
    } else {
        PG8_STAGE(PG8_SB(0, 0), cB, voffB); PG8_STAGE(PG8_SA(0, 0), cA, voffA); PG8_STAGE(PG8_SB(0, 1), cB + hstep, voffB); PG8_STAGE(PG8_SA(0, 1), cA + hstep, voffA);
        if (wr == 1) PG8_BAR;
        PG8_WAIT_V(4); PG8_BAR;
        PG8_STAGE(PG8_SB(1, 0), cB + kstep, voffB); PG8_STAGE(PG8_SA(1, 0), cA + kstep, voffA); PG8_STAGE(PG8_SB(1, 1), cB + hstep + kstep, voffB);
        PG8_WAIT_V(6); PG8_BAR;
    }
    for (;;) {
        const bool has_next = S.next(ui + 1, nxt);
        const char* nA = has_next ? (const char*)g.A + (size_t)nxt.pm * tstep : cA; const char* nB = has_next ? (const char*)g.Bt + (size_t)nxt.pn * tstep : cB;
        for (int t = 0; t < nt; t += 2) {
            const bool last = (t == nt - 2);
            const char* a1 = cA + (size_t)(t + 1) * kstep;
            const char* a2 = last ? nA : cA + (size_t)(t + 2) * kstep; const char* b2 = last ? nB : cB + (size_t)(t + 2) * kstep;
            const char* a3 = a2 + kstep; const char* b3 = b2 + kstep;
            if (last && has_next) S.a_ready(nxt);
            if constexpr (SP2) {
            PG8_LDB(B0, 0, 0); PG8_LDB(B1, 0, 1); PG8_SCHED; PG8_LDA(At, 0, 0); PG8_STAGE(PG8_SA(1, 1), a1 + hstep, voffA);
            PG8_WAIT_V(8); PG8_WAIT_L(0); PG8_BAR; PG8_MMA(0, 0, At, B0); PG8_MMA(0, 1, At, B1); PG8_BAR; PG8_SCHED;
            PG8_LDA(At, 0, 1); PG8_STAGE(PG8_SB(0, 0), b2, voffB); PG8_STAGE(PG8_SB(0, 1), b2 + hstep, voffB); PG8_STAGE(PG8_SA(0, 0), a2, voffA);
            PG8_WAIT_V(8); PG8_WAIT_L(0); PG8_BAR; PG8_MMA(1, 0, At, B0); PG8_MMA(1, 1, At, B1); PG8_BAR; PG8_SCHED;
            PG8_LDB(B0, 1, 0); PG8_LDB(B1, 1, 1); PG8_SCHED; PG8_LDA(At, 1, 0); PG8_STAGE(PG8_SA(0, 1), a2 + hstep, voffA);
            PG8_WAIT_V(8); PG8_WAIT_L(0); PG8_BAR; PG8_MMA(0, 0, At, B0); PG8_MMA(0, 1, At, B1); PG8_BAR; PG8_SCHED;
            PG8_LDA(At, 1, 1); PG8_STAGE(PG8_SB(1, 0), b3, voffB); PG8_STAGE(PG8_SB(1, 1), b3 + hstep, voffB); PG8_STAGE(PG8_SA(1, 0), a3, voffA);
            PG8_WAIT_V(8); PG8_WAIT_L(0); PG8_BAR; PG8_MMA(1, 0, At, B0); PG8_MMA(1, 1, At, B1); PG8_BAR; PG8_SCHED;
            } else {
            PG8_LDB(B0, 0, 0); PG8_SCHED; PG8_LDA(At, 0, 0); PG8_STAGE(PG8_SA(1, 1), a1 + hstep, voffA);
            PG8_WAIT_L(8); PG8_BAR; PG8_WAIT_L(0); PG8_MMA(0, 0, At, B0); PG8_BAR; PG8_SCHED;
            PG8_LDB(B1, 0, 1); PG8_STAGE(PG8_SB(0, 0), b2, voffB);
            PG8_BAR; PG8_WAIT_L(0); PG8_MMA(0, 1, At, B1); PG8_BAR;
            PG8_LDA(At, 0, 1); PG8_STAGE(PG8_SA(0, 0), a2, voffA);
            PG8_BAR; PG8_WAIT_L(0); PG8_MMA(1, 0, At, B0); PG8_BAR; PG8_SCHED;
            PG8_STAGE(PG8_SB(0, 1), b2 + hstep, voffB);
            PG8_WAIT_V(6); PG8_BAR; PG8_MMA(1, 1, At, B1); PG8_BAR;
            PG8_LDB(B0, 1, 0); PG8_SCHED; PG8_LDA(At, 1, 0); PG8_STAGE(PG8_SA(0, 1), a2 + hstep, voffA);
            PG8_WAIT_L(8); PG8_BAR; PG8_WAIT_L(0); PG8_MMA(0, 0, At, B0); PG8_BAR; PG8_SCHED;
            PG8_LDB(B1, 1, 1); PG8_STAGE(PG8_SB(1, 0), b3, voffB);
            PG8_BAR; PG8_WAIT_L(0); PG8_MMA(0, 1, At, B1); PG8_BAR;
            PG8_LDA(At, 1, 1); PG8_STAGE(PG8_SA(1, 0), a3, voffA);
            PG8_BAR; PG8_WAIT_L(0); PG8_MMA(1, 0, At, B0); PG8_BAR; PG8_SCHED;
            PG8_STAGE(PG8_SB(1, 1), b3 + hstep, voffB);
            PG8_WAIT_V(6); PG8_BAR; PG8_MMA(1, 1, At, B1); PG8_BAR;
            }
        }
        if constexpr (ALIGN_EPI) { if (wr == 0) PG8_BAR; }
        if constexpr (!Epi::AFTER_DRAIN) { E(acc, cur, wr, wc, fr, fq); S.done(cur); }
        if (!has_next) break;
#pragma unroll
        for (int a = 0; a < 2; ++a)
#pragma unroll
            for (int b = 0; b < 2; ++b)
#pragma unroll
                for (int m = 0; m < 4; ++m)
#pragma unroll
                    for (int n = 0; n < 2; ++n) acc[a][b][m][n] = (f32x4){0.f, 0.f, 0.f, 0.f};
        cur = nxt; cA = nA; cB = nB; ++ui;
        if constexpr (ALIGN_EPI) { if (wr == 1) PG8_BAR; }
    }
    PG8_WAIT_V(0);
    if constexpr (!ALIGN_EPI) { if (wr == 0) PG8_BAR; }
    PG8_BAR;
    if constexpr (Epi::AFTER_DRAIN) { E.fused(acc, cur, wr, wc, fr, fq, lds, wid, lane); S.done(cur); }
#undef PG8_SA
#undef PG8_SB
#undef PG8_STAGE
#undef PG8_LDA
#undef PG8_LDB
#undef PG8_MMA
#undef PG8_WAIT_V
#undef PG8_WAIT_L
#undef PG8_BAR
#undef PG8_SCHED
}
}

typedef unsigned short bf16_t;
typedef short bf16x8 __attribute__((ext_vector_type(8)));
typedef float f32x16 __attribute__((ext_vector_type(16)));
typedef float f32x4 __attribute__((ext_vector_type(4)));
typedef unsigned u32x4 __attribute__((ext_vector_type(4)));
typedef unsigned u32x2 __attribute__((ext_vector_type(2)));
#define LAS __attribute__((address_space(3)))
#define GAS __attribute__((address_space(1)))

#define SEQ 4096
#define NTOK 32768
#define DM 1024
#define DFF 2816
#define LOG2E 1.4426950408889634f
#define RMS_EPS 1e-6f
#define NTHREADS 512
#define LDS_BYTES (131072 + 16)
#define N_EVIN 1536
#define N_ODIN 3328

struct Params {
  const float *x, *p, *ffa_norm, *ffa_gu, *ffa_d, *mix_norm, *ffb_norm, *ffb_gu, *ffb_d, *ple_norm, *ple_g, *ple_p;
  const float *ev_in, *ev_sinks, *ev_cqn, *ev_uq, *ev_ckvn, *ev_ukv, *ev_out, *od_in, *od_bf, *od_out, *final_norm;
  float* out;
  bf16_t *hbA, *hbB, *pb, *act, *projb;
  float *ssqA, *ssqB, *ssq_cq, *ssq_ckv, *logf, *logc, *rope;
  unsigned* barw;
  bf16_t *w_gu_a0, *w_gu_a1, *w_gu_b0, *w_gu_b1, *w_d_a0, *w_d_a1, *w_d_b0, *w_d_b1;
  bf16_t *w_pg0, *w_pg1, *w_pp0, *w_pp1, *w_evin, *w_uq, *w_ukv, *w_evout, *w_odin, *w_odout;
  bf16_t *Qa, *Qb, *Ka, *Kn, *Kr, *Vta, *Vtb, *mix, *cqb, *ckvb;
  bf16_t *Qc, *Kc, *Vtc;
};

typedef __bf16 bf16x2_t __attribute__((ext_vector_type(2)));
typedef float f32x2_t __attribute__((ext_vector_type(2)));
__device__ __forceinline__ unsigned pk_bf16(float lo, float hi) {
  f32x2_t v = {lo, hi};
  bf16x2_t b = __builtin_convertvector(v, bf16x2_t);
  return __builtin_bit_cast(unsigned, b);
}
__device__ __forceinline__ bf16_t f2bf(float f) { return (bf16_t)(pk_bf16(f, 0.f) & 0xffffu); }
__device__ __forceinline__ float fast_exp2(float x) { return __builtin_amdgcn_exp2f(x); }
__device__ __forceinline__ float fast_rcp(float x) { return __builtin_amdgcn_rcpf(x); }
__device__ __forceinline__ float sigmoidf_fast(float z) { return fast_rcp(1.f + fast_exp2(-z * LOG2E)); }
__device__ __forceinline__ int perm_s(int s) { return (s & ~12) | ((s & 4) << 1) | ((s & 8) >> 1); }
__device__ __forceinline__ float bf_lo(unsigned w) { return __uint_as_float(w << 16); }
__device__ __forceinline__ float bf_hi(unsigned w) { return __uint_as_float(w & 0xffff0000u); }

__device__ __forceinline__ const Params& kparams() {
  const Params* q = (const Params*)__builtin_amdgcn_kernarg_segment_ptr();
  asm volatile("" : "+s"(q));
  return *q;
}
#define ACC_T const f32x4 (&acc)[2][2][4][2]
using pg8::Unit;
__device__ __forceinline__ int erow(const Unit& u, int ai, int wr, int m, int fr) { return u.pm * 256 + ai * 128 + wr * 64 + m * 16 + fr; }

template <int NP>
__device__ __forceinline__ void rows_rstd(const float* ssq, float invn, const Unit& u, int wr, int fr, int fq, float (&rs)[2][4]) {
#pragma unroll
  for (int ai = 0; ai < 2; ++ai)
#pragma unroll
    for (int m = 0; m < 4; ++m) {
      const int row = erow(u, ai, wr, m, fr);
      float s;
      if (NP == 16) {
        const f32x4 v = *(GAS const f32x4*)(ssq + (size_t)row * 16 + 4 * fq);
        s = (v[0] + v[1]) + (v[2] + v[3]);
        s += __shfl_xor(s, 16); s += __shfl_xor(s, 32);
      } else {
        const f32x4 v = *(GAS const f32x4*)(ssq + (size_t)row * 4);
        s = (v[0] + v[1]) + (v[2] + v[3]);
      }
      rs[ai][m] = rsqrtf(s * invn + RMS_EPS);
    }
}
template <int NP>
__device__ __forceinline__ float row_rstd(const float* ssq, float invn, int row, int fq) {
  float s;
  if (NP == 16) {
    const f32x4 v = *(GAS const f32x4*)(ssq + (size_t)row * 16 + 4 * fq);
    s = (v[0] + v[1]) + (v[2] + v[3]);
    s += __shfl_xor(s, 16); s += __shfl_xor(s, 32);
  } else {
    const f32x4 v = *(GAS const f32x4*)(ssq + (size_t)row * 4);
    s = (v[0] + v[1]) + (v[2] + v[3]);
  }
  return rsqrtf(s * invn + RMS_EPS);
}
#define ROW_FENCE() asm volatile("" ::: "memory")
__device__ __forceinline__ u32x4 pack8(const f32x4& a, const f32x4& b, float sc) {
  u32x4 w; w.x = pk_bf16(a[0] * sc, a[1] * sc); w.y = pk_bf16(a[2] * sc, a[3] * sc); w.z = pk_bf16(b[0] * sc, b[1] * sc); w.w = pk_bf16(b[2] * sc, b[3] * sc); return w;
}
__device__ __forceinline__ void store_vt8(bf16_t* base_  , const f32x4& a, const f32x4& b, float sc) {
  GAS bf16_t* base = (GAS bf16_t*)base_;
#pragma unroll
  for (int j = 0; j < 4; ++j) { base[(size_t)j * SEQ] = f2bf(a[j] * sc); base[(size_t)(4 + j) * SEQ] = f2bf(b[j] * sc); }
}
__device__ __forceinline__ u32x4 rope8(const f32x4& a, const f32x4& b, float sc, const float* tab  , int fq) {
  float v[8], p[8], o[8];
#pragma unroll
  for (int j = 0; j < 4; ++j) { v[j] = a[j] * sc; v[4 + j] = b[j] * sc; }
#pragma unroll
  for (int j = 0; j < 8; ++j) p[j] = __shfl_xor(v[j], 32);
  const f32x4 c0 = *(GAS const f32x4*)(tab + 8 * (fq & 1)), c1 = *(GAS const f32x4*)(tab + 8 * (fq & 1) + 4);
  const f32x4 s0 = *(GAS const f32x4*)(tab + 16 + 8 * (fq & 1)), s1 = *(GAS const f32x4*)(tab + 16 + 8 * (fq & 1) + 4);
#pragma unroll
  for (int j = 0; j < 8; ++j) {
    const float cc = j < 4 ? c0[j & 3] : c1[j & 3], sn = j < 4 ? s0[j & 3] : s1[j & 3];
    o[j] = (fq < 2) ? (v[j] * cc - p[j] * sn) : (p[j] * sn + v[j] * cc);
  }
  u32x4 w; w.x = pk_bf16(o[0], o[1]); w.y = pk_bf16(o[2], o[3]); w.z = pk_bf16(o[4], o[5]); w.w = pk_bf16(o[6], o[7]); return w;
}

struct EpiGU {
  static constexpr bool PERM = true, AFTER_DRAIN = false;
  const float* ssq; bf16_t* act;
  __device__ __forceinline__ void operator()(ACC_T, const Unit& u, int wr, int wc, int fr, int fq) const {
    float rs[2][4]; rows_rstd<16>(ssq, 1.0f / DM, u, wr, fr, fq, rs);
#pragma unroll
    for (int ai = 0; ai < 2; ++ai)
#pragma unroll
      for (int m = 0; m < 4; ++m) {
        const int row = erow(u, ai, wr, m, fr); const float r = rs[ai][m];
        float v[8];
#pragma unroll
        for (int n = 0; n < 2; ++n)
#pragma unroll
          for (int j = 0; j < 4; ++j) {
            const float g = acc[ai][0][m][n][j] * r, uu = acc[ai][1][m][n][j] * r;
            v[4 * n + j] = g * sigmoidf_fast(g) * uu;
          }
        u32x4 w; w.x = pk_bf16(v[0], v[1]); w.y = pk_bf16(v[2], v[3]); w.z = pk_bf16(v[4], v[5]); w.w = pk_bf16(v[6], v[7]);
        *(GAS u32x4*)(act + (size_t)row * DFF + 128 * u.pn + 32 * wc + 8 * fq) = w;
        ROW_FENCE();
      }
  }
};

struct EpiBf16Plain {
  static constexpr bool PERM = true, AFTER_DRAIN = false;
  bf16_t* o; int ld;
  __device__ __forceinline__ void operator()(ACC_T, const Unit& u, int wr, int wc, int fr, int fq) const {
#pragma unroll
    for (int ai = 0; ai < 2; ++ai)
#pragma unroll
      for (int m = 0; m < 4; ++m) {
        const int row = erow(u, ai, wr, m, fr);
#pragma unroll
        for (int bj = 0; bj < 2; ++bj)
          *(GAS u32x4*)(o + (size_t)row * ld + 256 * u.pn + 128 * bj + 32 * wc + 8 * fq) = pack8(acc[ai][bj][m][0], acc[ai][bj][m][1], 1.f);
        ROW_FENCE();
      }
  }
};

template <bool GATED, bool XIN>
struct EpiRes {
  static constexpr bool PERM = true, AFTER_DRAIN = false;
  const float* xin; const bf16_t* hres; bf16_t* hb; float* ssq_out; float scale; const float* ssq_in; const bf16_t* projb;
  __device__ __forceinline__ void operator()(ACC_T, const Unit& u, int wr, int wc, int fr, int fq) const {
    float rs[2][4];
    if (GATED) rows_rstd<16>(ssq_in, 1.0f / DM, u, wr, fr, fq, rs);
    const int cbase = 256 * u.pn + 32 * wc + 8 * fq;
    f32x4 xn0, xn1; u32x4 hnx, pnx;
    {
      const size_t off = (size_t)erow(u, 0, wr, 0, fr) * DM + cbase;
      if (XIN) { xn0 = *(GAS const f32x4*)(xin + off); xn1 = *(GAS const f32x4*)(xin + off + 4); } else hnx = *(GAS const u32x4*)(hres + off);
      if (GATED) pnx = *(GAS const u32x4*)(projb + off);
    }
    float ss = 0.f;
#pragma unroll
    for (int st = 0; st < 16; ++st) {
      const int ri = st >> 1, bj = st & 1, ai = ri >> 2, m = ri & 3;
      const int row = erow(u, ai, wr, m, fr);
      f32x4 h0, h1;
      if (XIN) { h0 = xn0; h1 = xn1; }
      else {
        h0[0] = bf_lo(hnx.x); h0[1] = bf_hi(hnx.x); h0[2] = bf_lo(hnx.y); h0[3] = bf_hi(hnx.y);
        h1[0] = bf_lo(hnx.z); h1[1] = bf_hi(hnx.z); h1[2] = bf_lo(hnx.w); h1[3] = bf_hi(hnx.w);
      }
      const u32x4 pw = pnx;
      if (st < 15) {
        const int rn = (st + 1) >> 1;
        const size_t offn = (size_t)erow(u, rn >> 2, wr, rn & 3, fr) * DM + cbase + 128 * ((st + 1) & 1);
        if (XIN) { xn0 = *(GAS const f32x4*)(xin + offn); xn1 = *(GAS const f32x4*)(xin + offn + 4); } else hnx = *(GAS const u32x4*)(hres + offn);
        if (GATED) pnx = *(GAS const u32x4*)(projb + offn);
      }
      const float rg = GATED ? rs[ai][m] : 0.f;
      const size_t off = (size_t)row * DM + cbase + 128 * bj;
      float pr[8];
      if (GATED) {
        pr[0] = bf_lo(pw.x); pr[1] = bf_hi(pw.x); pr[2] = bf_lo(pw.y); pr[3] = bf_hi(pw.y);
        pr[4] = bf_lo(pw.z); pr[5] = bf_hi(pw.z); pr[6] = bf_lo(pw.w); pr[7] = bf_hi(pw.w);
      }
      f32x4 v0, v1;
#pragma unroll
      for (int j = 0; j < 4; ++j) {
        const float a0 = acc[ai][bj][m][0][j], a1 = acc[ai][bj][m][1][j];
        const float d0 = GATED ? sigmoidf_fast(a0 * rg) * pr[j] : scale * a0;
        const float d1 = GATED ? sigmoidf_fast(a1 * rg) * pr[4 + j] : scale * a1;
        v0[j] = h0[j] + d0; v1[j] = h1[j] + d1;
        ss += v0[j] * v0[j] + v1[j] * v1[j];
      }
      *(GAS u32x4*)(hb + off) = pack8(v0, v1, 1.f);
      if (bj == 1) {
        ss += __shfl_xor(ss, 16); ss += __shfl_xor(ss, 32);
        if (fq == 0) ((GAS float*)ssq_out)[(size_t)row * 16 + 4 * u.pn + wc] = ss;
        ss = 0.f;
      }
    }
  }
};

struct EpiInEven {
  static constexpr bool PERM = true, AFTER_DRAIN = false;
  int dummy;
  __device__ __forceinline__ void operator()(ACC_T, const Unit& u, int wr, int wc, int fr, int fq) const {
    if (u.pn == 5 && wc != 0) return;
    const Params& P = kparams();
    const float *ssq = P.ssqA, *rope = P.rope; bf16_t *Qa = P.Qa, *Ka = P.Ka, *Vta = P.Vta, *cqb = P.cqb, *ckvb = P.ckvb, *Kr = P.Kr; float *ssq_cq = P.ssq_cq, *ssq_ckv = P.ssq_ckv;
    float rs[2][4]; rows_rstd<16>(ssq, 1.0f / DM, u, wr, fr, fq, rs);
#pragma unroll
    for (int ai = 0; ai < 2; ++ai)
#pragma unroll
      for (int m = 0; m < 4; ++m) {
        const int row = erow(u, ai, wr, m, fr), b = row >> 12, s = row & (SEQ - 1); const float r = rs[ai][m];
        const int c8 = 32 * wc + 8 * fq;
        if (u.pn < 2) {
#pragma unroll
          for (int bj = 0; bj < 2; ++bj)
            *(GAS u32x4*)(Qa + (size_t)row * 512 + 256 * u.pn + 128 * bj + c8) = pack8(acc[ai][bj][m][0], acc[ai][bj][m][1], r * (0.125f * LOG2E));
        } else if (u.pn == 2) {
          *(GAS u32x4*)(Ka + (size_t)row * 128 + c8) = pack8(acc[ai][0][m][0], acc[ai][0][m][1], r);
          store_vt8(Vta + ((size_t)(b * 2 + (c8 >> 6)) * 64 + (c8 & 63)) * SEQ + perm_s(s), acc[ai][1][m][0], acc[ai][1][m][1], r);
        } else if (u.pn == 3 || u.pn == 4) {
          bf16_t* o = (u.pn == 3 ? cqb : ckvb) + (size_t)row * 256 + c8;
          float ss = 0.f;
#pragma unroll
          for (int bj = 0; bj < 2; ++bj) {
            *(GAS u32x4*)(o + 128 * bj) = pack8(acc[ai][bj][m][0], acc[ai][bj][m][1], r);
#pragma unroll
            for (int j = 0; j < 4; ++j) { const float a0 = acc[ai][bj][m][0][j] * r, a1 = acc[ai][bj][m][1][j] * r; ss += a0 * a0 + a1 * a1; }
          }
          ss += __shfl_xor(ss, 16); ss += __shfl_xor(ss, 32);
          if (fq == 0) ((GAS float*)(u.pn == 3 ? ssq_cq : ssq_ckv))[(size_t)row * 4 + wc] = ss;
        } else {
          *(GAS u32x4*)(Kr + (size_t)row * 32 + 8 * fq) = rope8(acc[ai][0][m][0], acc[ai][0][m][1], r, rope + (size_t)s * 32, fq);
        }
        ROW_FENCE();
      }
  }
};

struct EpiUQ {
  static constexpr bool PERM = true, AFTER_DRAIN = false;
  const float *ssq_cq, *rope; bf16_t* Qb;
  __device__ __forceinline__ void operator()(ACC_T, const Unit& u, int wr, int wc, int fr, int fq) const {
    const float qs = 0.10206207261596577f * LOG2E;
    float rs[2][4]; rows_rstd<4>(ssq_cq, 1.0f / 256, u, wr, fr, fq, rs);
#pragma unroll
    for (int ai = 0; ai < 2; ++ai)
#pragma unroll
      for (int m = 0; m < 4; ++m) {
        const int row = erow(u, ai, wr, m, fr), s = row & (SEQ - 1); const float r = rs[ai][m] * qs;
#pragma unroll
        for (int bj = 0; bj < 2; ++bj) {
          const int F = 8 * u.pn + 4 * bj + wc;
          bf16_t* o = Qb + (size_t)row * 768 + 32 * F + 8 * fq;
          if (F % 3 != 2) *(GAS u32x4*)o = pack8(acc[ai][bj][m][0], acc[ai][bj][m][1], r);
          else *(GAS u32x4*)o = rope8(acc[ai][bj][m][0], acc[ai][bj][m][1], r, rope + (size_t)s * 32, fq);
        }
        ROW_FENCE();
      }
  }
};

struct EpiUKV {
  static constexpr bool PERM = true, AFTER_DRAIN = false;
  const float* ssq_ckv; bf16_t *Kn, *Vtb;
  __device__ __forceinline__ void operator()(ACC_T, const Unit& u, int wr, int wc, int fr, int fq) const {
    float rs[2][4]; rows_rstd<4>(ssq_ckv, 1.0f / 128, u, wr, fr, fq, rs);
#pragma unroll
    for (int ai = 0; ai < 2; ++ai)
#pragma unroll
      for (int m = 0; m < 4; ++m) {
        const int row = erow(u, ai, wr, m, fr), b = row >> 12, s = row & (SEQ - 1); const float r = rs[ai][m];
#pragma unroll
        for (int bj = 0; bj < 2; ++bj) {
          const int head = 2 * u.pn + bj, within = 32 * wc + 8 * fq;
          if (wc < 2) *(GAS u32x4*)(Kn + (size_t)row * 512 + head * 64 + within) = pack8(acc[ai][bj][m][0], acc[ai][bj][m][1], r);
          else store_vt8(Vtb + ((size_t)(b * 8 + head) * 64 + (within - 64)) * SEQ + perm_s(s), acc[ai][bj][m][0], acc[ai][bj][m][1], r);
        }
        ROW_FENCE();
      }
  }
};

struct EpiInOdd {
  static constexpr bool PERM = true, AFTER_DRAIN = false;
  int dummy;
  __device__ __forceinline__ void operator()(ACC_T, const Unit& u, int wr, int wc, int fr, int fq) const {
    if (u.pn == 12 && wc != 0) return;
    const Params& P = kparams();
    const float *ssq = P.ssqA, *bfp = P.od_bf; bf16_t *Qc = P.Qc, *Kc = P.Kc, *Vtc = P.Vtc; float* logf = P.logf;
    float rs[2][4]; rows_rstd<16>(ssq, 1.0f / DM, u, wr, fr, fq, rs);
#pragma unroll
    for (int ai = 0; ai < 2; ++ai)
#pragma unroll
      for (int m = 0; m < 4; ++m) {
        const int row = erow(u, ai, wr, m, fr), b = row >> 12, s = row & (SEQ - 1); const float r = rs[ai][m];
        if (u.pn < 8) {
          bf16_t* o = (u.pn < 4 ? Qc : Kc) + (size_t)row * 1024 + 256 * (u.pn & 3) + 32 * wc + 8 * fq;
          const float sc = u.pn < 4 ? r * (0.125f * LOG2E) : r;
#pragma unroll
          for (int bj = 0; bj < 2; ++bj) *(GAS u32x4*)(o + 128 * bj) = pack8(acc[ai][bj][m][0], acc[ai][bj][m][1], sc);
        } else if (u.pn < 12) {
#pragma unroll
          for (int bj = 0; bj < 2; ++bj) {
            const int c = 256 * (u.pn - 8) + 128 * bj + 32 * wc + 8 * fq;
            store_vt8(Vtc + ((size_t)(b * 16 + (c >> 6)) * 64 + (c & 63)) * SEQ + perm_s(s), acc[ai][bj][m][0], acc[ai][bj][m][1], r);
          }
        } else if (fq < 2) {
          f32x4 o0, o1;
          const f32x4 b0 = *(GAS const f32x4*)(bfp + 8 * fq), b1 = *(GAS const f32x4*)(bfp + 8 * fq + 4);
#pragma unroll
          for (int j = 0; j < 4; ++j) {
            const float x0 = acc[ai][0][m][0][j] * r + b0[j], x1 = acc[ai][0][m][1][j] * r + b1[j];
            o0[j] = fminf(x0, 0.f) - log1pf(__expf(-fabsf(x0)));
            o1[j] = fminf(x1, 0.f) - log1pf(__expf(-fabsf(x1)));
          }
          *(GAS f32x4*)(logf + (size_t)row * 16 + 8 * fq) = o0; *(GAS f32x4*)(logf + (size_t)row * 16 + 8 * fq + 4) = o1;
        }
        ROW_FENCE();
      }
  }
};

template <bool ALIGN = true, class Epi>
__device__ __forceinline__ void run_gemm(LAS unsigned char* lds, const bf16_t* A, const bf16_t* Bt, int N, int K, const Epi& E) {
  asm volatile("" : "+s"(N), "+s"(K));
  pg8::Gemm g{A, Bt, NTOK, N, K};
  pg8::StaticOrder S; S.init(NTOK, N, (int)gridDim.x, (int)blockIdx.x);
  pg8::gemm_phase<Epi, pg8::StaticOrder, ALIGN, true>(lds, g, S, E);
}

__device__ __forceinline__ void store_frag_bf16(bf16_t* base, const f32x16& a, float sc, int hi) {
#pragma unroll
  for (int g = 0; g < 4; ++g) {
    u32x2 w; w.x = pk_bf16(a[4 * g] * sc, a[4 * g + 1] * sc); w.y = pk_bf16(a[4 * g + 2] * sc, a[4 * g + 3] * sc);
    *(GAS u32x2*)(base + 8 * g + 4 * hi) = w;
  }
}
template <int MODE>
__device__ __forceinline__ void attn_unit(const Params& P, int b, int h, int qb, unsigned char* smem) {
  const int tid = tid_fresh(), lane = tid & 63, w = tid >> 6, r = lane & 31, hi = lane >> 5;
  constexpr int NKS = (MODE == 0) ? 6 : 4;
  const bf16_t *Q, *K, *Kr = nullptr, *Vt; bf16_t* O; int ldq, ldk; const float* cb = nullptr;
  float slope2 = 0.f, m_run = -1e30f, l_run = 0.f;
  if (MODE == 0) {
    Q = P.Qb + (size_t)b * SEQ * 768 + h * 96; ldq = 768; K = P.Kn + (size_t)b * SEQ * 512 + h * 64; ldk = 512;
    Kr = P.Kr + (size_t)b * SEQ * 32; Vt = P.Vtb + (size_t)(b * 8 + h) * 64 * SEQ; O = P.mix + (size_t)b * SEQ * 1024 + 512 + h * 64;
  } else if (MODE == 1) {
    Q = P.Qc + (size_t)b * SEQ * 1024 + h * 64; ldq = 1024; K = P.Kc + (size_t)b * SEQ * 1024 + h * 64; ldk = 1024;
    Vt = P.Vtc + (size_t)(b * 16 + h) * 64 * SEQ; O = P.Qc + (size_t)b * SEQ * 1024 + h * 64; cb = P.logc + (size_t)(b * 16 + h) * SEQ;
  } else {
    Q = P.Qa + (size_t)b * SEQ * 512 + h * 64; ldq = 512; K = P.Ka + (size_t)b * SEQ * 128 + (h >> 2) * 64; ldk = 128;
    Vt = P.Vta + (size_t)(b * 2 + (h >> 2)) * 64 * SEQ; O = P.mix + (size_t)b * SEQ * 1024 + h * 64;
    slope2 = exp2f(-(float)(h + 1)) * LOG2E;
    m_run = ((GAS const float*)P.ev_sinks)[h] * LOG2E; l_run = hi ? 0.f : 1.f;
  }
  const int q0 = qb * 256, qw0 = q0 + 32 * w, qi = qw0 + r;
  bf16x8 qf[NKS];
#pragma unroll
  for (int ks = 0; ks < NKS; ++ks) qf[ks] = *(GAS const bf16x8*)(Q + (size_t)qi * ldq + 16 * ks + 8 * hi);
  f32x16 oacc[2];
#pragma unroll
  for (int i = 0; i < 16; ++i) { oacc[0][i] = 0.f; oacc[1][i] = 0.f; }
  const int kt_end = 4 * qb + 4;
  const int kt_beg = (MODE == 2) ? (qb > 0 ? 4 * qb - 2 : 0) : 0;
  const int srow = tid >> 3, sch = tid & 7;
  const unsigned soff = srow * 128 + ((sch ^ ((srow >> 1) & 7)) << 4);
  const int rrow = (tid & 255) >> 2, rch = tid & 3;
  const unsigned roff = 16384u + rrow * 64 + ((rch ^ ((rrow >> 2) & 3)) << 4);
  constexpr unsigned BUFSZ = 20736u;
  u32x4 rk, rv, rr_; f32x4 rc;
  auto gload = [&](int kt) {
    const int k0 = kt * 64;
    rk = *(GAS const u32x4*)(K + (size_t)(k0 + srow) * ldk + sch * 8);
    rv = *(GAS const u32x4*)(Vt + (size_t)srow * SEQ + k0 + sch * 8);
    if (MODE == 0) { if (tid < 256) rr_ = *(GAS const u32x4*)(Kr + (size_t)(k0 + rrow) * 32 + rch * 8); }
    if (MODE == 1) { if (tid < 16) rc = *(GAS const f32x4*)(cb + k0 + tid * 4); }
  };
  auto sstore = [&](unsigned buf) {
    *(u32x4*)(smem + buf + soff) = rk;
    *(u32x4*)(smem + buf + 8192 + soff) = rv;
    if (MODE == 0) { if (tid < 256) *(u32x4*)(smem + buf + roff) = rr_; }
    if (MODE == 1) { if (tid < 16) *(f32x4*)(smem + buf + 20480 + tid * 16) = rc; }
  };
  gload(kt_beg); sstore(0); __syncthreads();
  const int swz = (r >> 1) & 7, swr = (r >> 2) & 3;
  for (int kt = kt_beg; kt < kt_end; ++kt) {
    const unsigned cur = ((kt - kt_beg) & 1) * BUFSZ, nxt = BUFSZ - cur;
    const bool more = (kt + 1 < kt_end);
    if (more) gload(kt + 1);
    const int k0 = kt * 64;
    bool active = (k0 <= qw0 + 31);
    if (MODE == 2) active = active && (k0 + 63 > qw0 - 128);
    if (active) {
      f32x16 sacc[2];
#pragma unroll
      for (int kb = 0; kb < 2; ++kb) {
        f32x16 c0;
        if (MODE == 1) {
#pragma unroll
          for (int g = 0; g < 4; ++g) {
            const f32x4 c4 = *(const f32x4*)(smem + cur + 20480 + (32 * kb + 8 * g + 4 * hi) * 4);
            c0[4 * g] = c4[0]; c0[4 * g + 1] = c4[1]; c0[4 * g + 2] = c4[2]; c0[4 * g + 3] = c4[3];
          }
        } else {
#pragma unroll
          for (int i = 0; i < 16; ++i) c0[i] = 0.f;
        }
        sacc[kb] = c0;
#pragma unroll
        for (int ks = 0; ks < 4; ++ks) {
          bf16x8 kf = *(const bf16x8*)(smem + cur + (32 * kb + r) * 128 + (((2 * ks + hi) ^ swz) << 4));
          sacc[kb] = __builtin_amdgcn_mfma_f32_32x32x16_bf16(kf, qf[ks], sacc[kb], 0, 0, 0);
        }
        if (MODE == 0) {
#pragma unroll
          for (int ks = 0; ks < 2; ++ks) {
            bf16x8 kf = *(const bf16x8*)(smem + cur + 16384 + (32 * kb + r) * 64 + (((2 * ks + hi) ^ swr) << 4));
            sacc[kb] = __builtin_amdgcn_mfma_f32_32x32x16_bf16(kf, qf[4 + ks], sacc[kb], 0, 0, 0);
          }
        }
      }
      if (MODE == 2) {
#pragma unroll
        for (int kb = 0; kb < 2; ++kb)
#pragma unroll
          for (int i = 0; i < 16; ++i) {
            const int key = k0 + 32 * kb + 8 * (i >> 2) + 4 * hi + (i & 3);
            const int dist = qi - key;
            const float v = sacc[kb][i] - slope2 * (float)dist;
            sacc[kb][i] = (dist >= 0 && dist < 128) ? v : -INFINITY;
          }
      } else if (k0 + 63 > qw0) {
#pragma unroll
        for (int kb = 0; kb < 2; ++kb)
#pragma unroll
          for (int i = 0; i < 16; ++i) {
            const int key = k0 + 32 * kb + 8 * (i >> 2) + 4 * hi + (i & 3);
            if (key > qi) sacc[kb][i] = -INFINITY;
          }
      }
      float mx = sacc[0][0];
#pragma unroll
      for (int i = 1; i < 16; ++i) mx = fmaxf(mx, sacc[0][i]);
#pragma unroll
      for (int i = 0; i < 16; ++i) mx = fmaxf(mx, sacc[1][i]);
      mx = fmaxf(mx, __shfl_xor(mx, 32));
      if (__any(mx > m_run + 24.0f)) {
        const float m_new = fmaxf(m_run, mx);
        const float alpha = fast_exp2(m_run - m_new);
        m_run = m_new; l_run *= alpha;
        const f32x2_t a2 = {alpha, alpha};
#pragma unroll
        for (int i = 0; i < 8; ++i) {
          f32x2_t t0 = {oacc[0][2 * i], oacc[0][2 * i + 1]}, t1 = {oacc[1][2 * i], oacc[1][2 * i + 1]};
          t0 *= a2; t1 *= a2;
          oacc[0][2 * i] = t0[0]; oacc[0][2 * i + 1] = t0[1]; oacc[1][2 * i] = t1[0]; oacc[1][2 * i + 1] = t1[1];
        }
      }
      {
        const f32x2_t m2 = {m_run, m_run};
        f32x2_t ps2 = {0.f, 0.f};
#pragma unroll
        for (int kb = 0; kb < 2; ++kb)
#pragma unroll
          for (int i = 0; i < 8; ++i) {
            f32x2_t t = {sacc[kb][2 * i], sacc[kb][2 * i + 1]};
            t -= m2;
            f32x2_t e; e[0] = fast_exp2(t[0]); e[1] = fast_exp2(t[1]);
            ps2 += e;
            sacc[kb][2 * i] = e[0]; sacc[kb][2 * i + 1] = e[1];
          }
        l_run += ps2[0] + ps2[1];
      }
      bf16x8 pf[4];
#pragma unroll
      for (int a = 0; a < 4; ++a) {
        const int kb = a >> 1, o8 = (a & 1) * 8;
        u32x4 u;
        u.x = pk_bf16(sacc[kb][o8 + 0], sacc[kb][o8 + 1]); u.y = pk_bf16(sacc[kb][o8 + 2], sacc[kb][o8 + 3]);
        u.z = pk_bf16(sacc[kb][o8 + 4], sacc[kb][o8 + 5]); u.w = pk_bf16(sacc[kb][o8 + 6], sacc[kb][o8 + 7]);
        pf[a] = __builtin_bit_cast(bf16x8, u);
      }
#pragma unroll
      for (int db = 0; db < 2; ++db)
#pragma unroll
        for (int a = 0; a < 4; ++a) {
          bf16x8 vf = *(const bf16x8*)(smem + cur + 8192 + (32 * db + r) * 128 + (((2 * a + hi) ^ swz) << 4));
          oacc[db] = __builtin_amdgcn_mfma_f32_32x32x16_bf16(vf, pf[a], oacc[db], 0, 0, 0);
        }
    }
    if (more) sstore(nxt);
    __syncthreads();
  }
  const float lt = l_run + __shfl_xor(l_run, 32);
  const float inv = 1.0f / lt;
#pragma unroll
  for (int db = 0; db < 2; ++db) store_frag_bf16(O + (size_t)qi * 1024 + 32 * db, oacc[db], inv, hi);
}

__device__ __forceinline__ void phase_attn_even(const Params& P, unsigned char* smem) {
  const int bid = blockIdx.x, G = gridDim.x;
  for (int j = 0;; ++j) {
    const int u = j * G + ((j & 1) ? (G - 1 - bid) : bid);
    if (u >= 1024) break;
    const int qb = 15 - (u >> 6), pr = u & 63;
    attn_unit<0>(P, pr >> 3, pr & 7, qb, smem);
  }
  for (int u = bid; u < 1024; u += G) {
    const int qb = u >> 6, pr = u & 63;
    attn_unit<2>(P, pr >> 3, pr & 7, qb, smem);
  }
}
__device__ __forceinline__ void phase_attn_odd(const Params& P, unsigned char* smem) {
  const int bid = blockIdx.x, G = gridDim.x;
  for (int j = 0;; ++j) {
    const int u = j * G + ((j & 1) ? (G - 1 - bid) : bid);
    if (u >= 2048) break;
    const int qb = 15 - (u >> 7), pr = u & 127;
    attn_unit<1>(P, pr >> 4, pr & 15, qb, smem);
  }
}

__device__ __forceinline__ void phase_scan(const Params& P) {
  const int tid = tid_fresh(); const int lane = tid & 63, gw = blockIdx.x * (NTHREADS / 64) + (tid >> 6), nw = gridDim.x * (NTHREADS / 64);
  for (int seq = gw; seq < 128; seq += nw) {
    const int b = seq >> 4, h = seq & 15;
    GAS const float* src = (GAS const float*)(P.logf + ((size_t)b * SEQ + lane * 64) * 16 + h);
    float tot = 0.f;
#pragma unroll 16
    for (int i = 0; i < 64; ++i) tot += src[(size_t)i * 16];
    float inc = tot;
#pragma unroll
    for (int d = 1; d < 64; d <<= 1) { const float o = __shfl_up(inc, d); if (lane >= d) inc += o; }
    float run = inc - tot;
    float* dst = P.logc + (size_t)seq * SEQ + lane * 64;
#pragma unroll 4
    for (int i = 0; i < 64; i += 4) {
      f32x4 o;
      run += src[(size_t)i * 16]; o[0] = -run * LOG2E;
      run += src[(size_t)(i + 1) * 16]; o[1] = -run * LOG2E;
      run += src[(size_t)(i + 2) * 16]; o[2] = -run * LOG2E;
      run += src[(size_t)(i + 3) * 16]; o[3] = -run * LOG2E;
      *(GAS f32x4*)(dst + i) = o;
    }
  }
}

struct ConvT { int tile; bool valid; };
__device__ __forceinline__ void conv_w_pair(const float* __restrict__ src, int K, int N, bf16_t* __restrict__ dst, int dstK, const float* __restrict__ gain, int mode,
                                            ConvT ta, ConvT tb, int tiles_k, int tid0, unsigned char* smem) {
  const int tid = tid0 & 255, half = tid0 >> 8;
  const int kk = tid >> 4, rloc = (tid & 15) * 4;
  f32x4 v[2][4]; float gs[2][4];
#pragma unroll
  for (int q = 0; q < 2; ++q) {
    const ConvT t = q ? tb : ta;
    const int tk = t.tile % tiles_k, tr = t.tile / tiles_k, k0 = tk * 64, rho0 = tr * 64;
    int col = rho0 + rloc;
    if (mode == 1) { const int pn = rho0 >> 8, wi = rho0 & 255; col = (wi >> 7) * DFF + 128 * pn + (wi & 127) + rloc; }
    else if (mode == 2) { col = (col < 1152) ? col : (col < 1280 ? N : (col < 1312 ? col - 128 : N)); }
#pragma unroll
    for (int i = 0; i < 4; ++i) {
      const int k = kk + 16 * i;
      v[q][i] = (f32x4){0.f, 0.f, 0.f, 0.f}; gs[q][i] = 1.f;
      if (t.valid && col < N) v[q][i] = *(GAS const f32x4*)(src + (size_t)(k0 + k) * N + col);
      if (gain) gs[q][i] = ((GAS const float*)gain)[k0 + k];
    }
  }
#pragma unroll
  for (int q = 0; q < 2; ++q) {
    float* lds = (float*)(smem + (half * 2 + q) * 16640);
#pragma unroll
    for (int i = 0; i < 4; ++i) {
      const int k = kk + 16 * i;
      lds[k * 65 + rloc + 0] = v[q][i][0] * gs[q][i]; lds[k * 65 + rloc + 1] = v[q][i][1] * gs[q][i];
      lds[k * 65 + rloc + 2] = v[q][i][2] * gs[q][i]; lds[k * 65 + rloc + 3] = v[q][i][3] * gs[q][i];
    }
  }
  __syncthreads();
#pragma unroll
  for (int q = 0; q < 2; ++q) {
    const ConvT t = q ? tb : ta;
    if (t.valid) {
      const float* lds = (const float*)(smem + (half * 2 + q) * 16640);
      const int tk = t.tile % tiles_k, tr = t.tile / tiles_k, k0 = tk * 64, rho0 = tr * 64;
      const int rho = tid >> 2, ks = tid & 3;
      unsigned wv[8];
#pragma unroll
      for (int j = 0; j < 8; ++j) wv[j] = pk_bf16(lds[(ks * 16 + 2 * j) * 65 + rho], lds[(ks * 16 + 2 * j + 1) * 65 + rho]);
      u32x4 a = {wv[0], wv[1], wv[2], wv[3]}, b = {wv[4], wv[5], wv[6], wv[7]};
      bf16_t* o = dst + (size_t)(rho0 + rho) * dstK + k0 + ks * 16;
      *(GAS u32x4*)o = a; *(GAS u32x4*)(o + 8) = b;
    }
  }
  __syncthreads();
}

struct WJob { const float* src; bf16_t* dst; const float* gain; int K, N, NP, mode, dstK; };

__device__ __forceinline__ void phase_prologue(const Params& P, unsigned char* smem) {
  const int bid = blockIdx.x, G = gridDim.x, tid = tid_fresh(), lane = tid & 63;
  {
    const int NJ = 18;
    for (int jb = 0; jb < NJ; ++jb) {
      WJob J;
      switch (jb) {
        case 0: J = {P.ffa_gu, P.w_gu_a0, P.ffa_norm, DM, 2 * DFF, 2 * DFF, 1, DM}; break;
        case 1: J = {P.ffa_gu + (size_t)DM * 2 * DFF, P.w_gu_a1, P.ffa_norm + DM, DM, 2 * DFF, 2 * DFF, 1, DM}; break;
        case 2: J = {P.ffb_gu, P.w_gu_b0, P.ffb_norm, DM, 2 * DFF, 2 * DFF, 1, DM}; break;
        case 3: J = {P.ffb_gu + (size_t)DM * 2 * DFF, P.w_gu_b1, P.ffb_norm + DM, DM, 2 * DFF, 2 * DFF, 1, DM}; break;
        case 4: J = {P.ffa_d, P.w_d_a0, nullptr, DFF, DM, DM, 0, DFF}; break;
        case 5: J = {P.ffa_d + (size_t)DFF * DM, P.w_d_a1, nullptr, DFF, DM, DM, 0, DFF}; break;
        case 6: J = {P.ffb_d, P.w_d_b0, nullptr, DFF, DM, DM, 0, DFF}; break;
        case 7: J = {P.ffb_d + (size_t)DFF * DM, P.w_d_b1, nullptr, DFF, DM, DM, 0, DFF}; break;
        case 8: J = {P.ple_g, P.w_pg0, P.ple_norm, DM, DM, DM, 0, DM}; break;
        case 9: J = {P.ple_g + (size_t)DM * DM, P.w_pg1, P.ple_norm + DM, DM, DM, DM, 0, DM}; break;
        case 10: J = {P.ple_p, P.w_pp0, nullptr, 256, DM, DM, 0, 256}; break;
        case 11: J = {P.ple_p + (size_t)256 * DM, P.w_pp1, nullptr, 256, DM, DM, 0, 256}; break;
        case 12: J = {P.ev_in, P.w_evin, P.mix_norm, DM, 1184, N_EVIN, 2, DM}; break;
        case 13: J = {P.ev_uq, P.w_uq, P.ev_cqn, 256, 768, 768, 0, 256}; break;
        case 14: J = {P.ev_ukv, P.w_ukv, P.ev_ckvn, 128, 1024, 1024, 0, 256}; break;
        case 15: J = {P.ev_out, P.w_evout, nullptr, DM, DM, DM, 0, DM}; break;
        case 16: J = {P.od_in, P.w_odin, P.mix_norm + DM, DM, 3088, N_ODIN, 0, DM}; break;
        default: J = {P.od_out, P.w_odout, nullptr, DM, DM, DM, 0, DM}; break;
      }
      const int tiles_k = J.K >> 6, ntiles = tiles_k * (J.NP >> 6);
      for (int t0 = 2 * bid; t0 < ntiles; t0 += 4 * G) {
        const int ta = t0 + (tid >> 8), tb = ta + 2 * G;
        conv_w_pair(J.src, J.K, J.N, J.dst, J.dstK, J.gain, J.mode, ConvT{ta < ntiles ? ta : 0, ta < ntiles}, ConvT{tb < ntiles ? tb : 0, tb < ntiles}, tiles_k, tid, smem);
      }
    }
    for (int i = bid * NTHREADS + tid; i < 1024 * 16; i += G * NTHREADS) {
      const int row = i >> 4, c = i & 15;
      *(GAS u32x4*)(P.w_ukv + (size_t)row * 256 + 128 + c * 8) = (u32x4){0u, 0u, 0u, 0u};
    }
  }
  {
    const int gw = bid * (NTHREADS / 64) + (tid >> 6), nw = G * (NTHREADS / 64);
    for (int m = gw; m < NTOK; m += 2 * nw) {
      f32x4 v[2][4];
#pragma unroll
      for (int q = 0; q < 2; ++q)
#pragma unroll
        for (int i = 0; i < 4; ++i) { if (m + q * nw < NTOK) v[q][i] = *(GAS const f32x4*)(P.x + (size_t)(m + q * nw) * DM + i * 256 + lane * 4); }
#pragma unroll
      for (int q = 0; q < 2; ++q) {
        const int mm = m + q * nw;
        if (mm >= NTOK) break;
        float ss = 0.f;
#pragma unroll
        for (int i = 0; i < 4; ++i) {
          ss += (v[q][i][0] * v[q][i][0] + v[q][i][1] * v[q][i][1]) + (v[q][i][2] * v[q][i][2] + v[q][i][3] * v[q][i][3]);
          u32x2 w; w.x = pk_bf16(v[q][i][0], v[q][i][1]); w.y = pk_bf16(v[q][i][2], v[q][i][3]);
          *(GAS u32x2*)(P.hbB + (size_t)mm * DM + i * 256 + lane * 4) = w;
        }
#pragma unroll
        for (int d = 32; d >= 1; d >>= 1) ss += __shfl_xor(ss, d);
        if (lane < 16) ((GAS float*)P.ssqB)[(size_t)mm * 16 + lane] = (lane == 0) ? ss : 0.f;
      }
    }
  }
  {
    const size_t n8 = (size_t)2 * NTOK * 256 / 8, stride = (size_t)G * NTHREADS;
    for (size_t i = (size_t)bid * NTHREADS + tid; i < n8; i += 4 * stride) {
      f32x4 a[4], b[4];
#pragma unroll
      for (int q = 0; q < 4; ++q) { const size_t ii = i + q * stride; if (ii < n8) { a[q] = *(GAS const f32x4*)(P.p + ii * 8); b[q] = *(GAS const f32x4*)(P.p + ii * 8 + 4); } }
#pragma unroll
      for (int q = 0; q < 4; ++q) { const size_t ii = i + q * stride; if (ii < n8) {
        u32x4 w; w.x = pk_bf16(a[q][0], a[q][1]); w.y = pk_bf16(a[q][2], a[q][3]); w.z = pk_bf16(b[q][0], b[q][1]); w.w = pk_bf16(b[q][2], b[q][3]);
        *(GAS u32x4*)(P.pb + ii * 8) = w; } }
    }
  }
  {
    for (int i = bid * NTHREADS + tid; i < SEQ * 16; i += G * NTHREADS) {
      const int s = i >> 4, j = i & 15;
      const float inv = (float)exp2(-(double)j * (13.287712379549449 / 16.0));
      const float ang = (float)s * inv;
      double rv = (double)ang * 0.15915494309189535; rv -= floor(rv);
      const float fr = (float)rv;
      ((GAS float*)P.rope)[(size_t)s * 32 + j] = __builtin_amdgcn_cosf(fr);
      ((GAS float*)P.rope)[(size_t)s * 32 + 16 + j] = __builtin_amdgcn_sinf(fr);
    }
  }
}

__device__ __forceinline__ void phase_final(const Params& P) {
  const int tid = tid_fresh(); const int lane = tid & 63, gw = blockIdx.x * (NTHREADS / 64) + (tid >> 6), nw = gridDim.x * (NTHREADS / 64);
  for (int m = gw; m < NTOK; m += nw) {
    const f32x4 q = *(GAS const f32x4*)(P.ssqB + (size_t)m * 16 + 4 * (lane & 3));
    u32x4 hv[2];
#pragma unroll
    for (int i = 0; i < 2; ++i) hv[i] = *(GAS const u32x4*)(P.hbB + (size_t)m * DM + i * 512 + lane * 8);
    float s = (q[0] + q[1]) + (q[2] + q[3]);
    s += __shfl_xor(s, 1); s += __shfl_xor(s, 2);
    const float rs = rsqrtf(s * (1.0f / DM) + RMS_EPS);
    float* row = P.out + (size_t)m * DM;
#pragma unroll
    for (int i = 0; i < 2; ++i) {
      const f32x4 g0 = *(GAS const f32x4*)(P.final_norm + i * 512 + lane * 8), g1 = *(GAS const f32x4*)(P.final_norm + i * 512 + lane * 8 + 4);
      f32x4 o0, o1;
      o0[0] = bf_lo(hv[i].x) * rs * g0[0]; o0[1] = bf_hi(hv[i].x) * rs * g0[1]; o0[2] = bf_lo(hv[i].y) * rs * g0[2]; o0[3] = bf_hi(hv[i].y) * rs * g0[3];
      o1[0] = bf_lo(hv[i].z) * rs * g1[0]; o1[1] = bf_hi(hv[i].z) * rs * g1[1]; o1[2] = bf_lo(hv[i].w) * rs * g1[2]; o1[3] = bf_hi(hv[i].w) * rs * g1[3];
      *(GAS f32x4*)(row + i * 512 + lane * 8) = o0; *(GAS f32x4*)(row + i * 512 + lane * 8 + 4) = o1;
    }
  }
}

#define XB_TMO      128
#define XB_XCNT(j)  (256  + 64 * (j))
#define XB_XSUB(j)  (1280 + 64 * (j))
#define XB_XGEN(j)  (2304 + 64 * (j))
#define XB_TOP      3328
#define XB_TOPGEN   3392
#define XCD_BAR_WORDS 3456
#define XB_SPIN_CAP (1u << 18)

__device__ __forceinline__ unsigned xb_ld(unsigned* p)              { return __hip_atomic_load(p, __ATOMIC_RELAXED, __HIP_MEMORY_SCOPE_AGENT); }
__device__ __forceinline__ unsigned xb_add(unsigned* p, unsigned v) { return __hip_atomic_fetch_add(p, v, __ATOMIC_RELAXED, __HIP_MEMORY_SCOPE_AGENT); }
__device__ __forceinline__ unsigned xb_xcc_id() { return (unsigned)__builtin_amdgcn_s_getreg((3 << 11) | 20) & 0xFu; }
#define XB_SPIN(cond, bar) do { unsigned _sp = 0; while (cond) { __builtin_amdgcn_s_sleep(1); \
    if ((++_sp & 255u) == 0u) { if (xb_ld(&(bar)[XB_TMO])) break; if (_sp > XB_SPIN_CAP) { atomicAdd(&(bar)[XB_TMO], 1u); break; } } } } while (0)

struct XcdBarrier {
    unsigned* bar; unsigned x;
    volatile LAS unsigned* st;
};

__device__ __forceinline__ XcdBarrier xcd_barrier_post(unsigned* bar, volatile LAS unsigned* st) {
    XcdBarrier b; b.bar = bar; b.x = xb_xcc_id(); b.st = st;
    if (threadIdx.x == 0) (void)xb_add(&bar[XB_XCNT(b.x)], 1u);
    return b;
}
__device__ __forceinline__ void xcd_barrier_complete(unsigned* bar, unsigned x, unsigned& nloc, unsigned& nx) {
    const unsigned G = gridDim.x * gridDim.y * gridDim.z;
    unsigned sum, cnt, mine, sp = 0u;
    for (;;) {
        sum = 0u; cnt = 0u; mine = 0u;
#pragma unroll
        for (unsigned j = 0; j < 16; ++j) { const unsigned c = xb_ld(&bar[XB_XCNT(j)]); sum += c; cnt += (c > 0u) ? 1u : 0u; mine = (j == x) ? c : mine; }
        if (sum == G) break;
        __builtin_amdgcn_s_sleep(1);
        if ((++sp & 255u) == 0u) { if (xb_ld(&bar[XB_TMO])) break; if (sp > XB_SPIN_CAP) { atomicAdd(&bar[XB_TMO], 1u); break; } }
    }
    nloc = mine > 0u ? mine : 1u; nx = cnt > 0u ? cnt : 1u;
}

__device__ __forceinline__ void xcd_barrier(const XcdBarrier& b) {
    asm volatile("s_waitcnt vmcnt(0)" ::: "memory");
    __syncthreads();
    if (threadIdx.x == 0) {
        unsigned* bar = b.bar;
        __builtin_amdgcn_s_waitcnt(0);
        unsigned nloc = b.st[0], nx = b.st[1];
        if (nloc == 0u) { xcd_barrier_complete(bar, b.x, nloc, nx); b.st[0] = nloc; b.st[1] = nx; }
        const unsigned old = xb_add(&bar[XB_XSUB(b.x)], 1u);
        const unsigned gen = old / nloc;
        if (old + 1u == (gen + 1u) * nloc) {
            __builtin_amdgcn_fence(__ATOMIC_RELEASE, "agent");
            asm volatile("s_waitcnt vmcnt(0)" ::: "memory");
            const unsigned og = xb_add(&bar[XB_TOP], 1u);
            const unsigned tg = og / nx;
            if (og + 1u == (tg + 1u) * nx) xb_add(&bar[XB_TOPGEN], 1u);
            else XB_SPIN(xb_ld(&bar[XB_TOPGEN]) == tg, bar);
            __builtin_amdgcn_fence(__ATOMIC_ACQUIRE, "agent");
            xb_add(&bar[XB_XGEN(b.x)], 1u);
            asm volatile("s_waitcnt vmcnt(0)" ::: "memory");
        } else {
            XB_SPIN(xb_ld(&bar[XB_XGEN(b.x)]) == gen, bar);
            __builtin_amdgcn_fence(__ATOMIC_ACQUIRE, "agent");
            asm volatile("s_waitcnt vmcnt(0)" ::: "memory");
        }
    }
    __syncthreads();
}


#define PH(...) { const Params& P = kparams(); __VA_ARGS__ } xcd_barrier(xb);

template <int L>
__device__ __forceinline__ void run_layer(const XcdBarrier& xb, unsigned char* smem, LAS unsigned char* lds) {
  PH( EpiGU E{P.ssqB, P.act}; run_gemm(lds, P.hbB, L ? P.w_gu_a1 : P.w_gu_a0, 2 * DFF, DM, E); )
  PH( EpiRes<false, false> E{nullptr, P.hbB, P.hbA, P.ssqA, 0.5f, nullptr, nullptr}; run_gemm(lds, P.act, L ? P.w_d_a1 : P.w_d_a0, DM, DFF, E); )
  if (L == 0) {
    PH( EpiInEven E{0}; run_gemm(lds, P.hbA, P.w_evin, N_EVIN, DM, E); )
    PH( { EpiUQ E{P.ssq_cq, P.rope, P.Qb}; run_gemm(lds, P.cqb, P.w_uq, 768, 256, E); }
        { EpiUKV E{P.ssq_ckv, P.Kn, P.Vtb}; run_gemm(lds, P.ckvb, P.w_ukv, 1024, 256, E); } )
    PH( phase_attn_even(P, smem); )
  } else {
    PH( EpiInOdd E{0}; run_gemm(lds, P.hbA, P.w_odin, N_ODIN, DM, E); )
    PH( phase_scan(P); )
    PH( phase_attn_odd(P, smem); )
  }
  PH( EpiRes<false, false> E{nullptr, P.hbA, P.hbA, P.ssqA, 1.0f, nullptr, nullptr}; run_gemm(lds, L ? P.Qc : P.mix, L ? P.w_odout : P.w_evout, DM, DM, E); )
  PH( EpiGU E{P.ssqA, P.act}; run_gemm(lds, P.hbA, L ? P.w_gu_b1 : P.w_gu_b0, 2 * DFF, DM, E); )
  PH( EpiRes<false, false> E{nullptr, P.hbA, P.hbA, P.ssqA, 0.5f, nullptr, nullptr}; run_gemm(lds, P.act, L ? P.w_d_b1 : P.w_d_b0, DM, DFF, E); )
  PH( { EpiBf16Plain E{P.projb, DM}; run_gemm(lds, P.pb + (size_t)L * NTOK * 256, L ? P.w_pp1 : P.w_pp0, DM, 256, E); }
      { EpiRes<true, false> E{nullptr, P.hbA, P.hbB, P.ssqB, 0.f, P.ssqA, P.projb}; run_gemm(lds, P.hbA, L ? P.w_pg1 : P.w_pg0, DM, DM, E); } )
}

__global__ void __launch_bounds__(NTHREADS, 2) k_mega(Params Pdummy) {
  extern __shared__ __attribute__((aligned(16))) unsigned char lds_dyn[];
  unsigned char* smem = lds_dyn;
  LAS unsigned char* lds = (LAS unsigned char*)lds_dyn;
  cg::grid_group grid = cg::this_grid();
  if (threadIdx.x < 4) ((LAS unsigned*)(lds + 131072))[threadIdx.x] = 0u;
  __syncthreads();
  unsigned* barw; { const Params& P = kparams(); barw = P.barw; }
  const XcdBarrier xb = xcd_barrier_post(barw, (volatile LAS unsigned*)(lds + 131072));
  { const Params& P = kparams(); phase_prologue(P, smem); }
  grid.sync();
  run_layer<0>(xb, smem, lds);
  run_layer<1>(xb, smem, lds);
  { const Params& P = kparams(); phase_final(P); }
}

extern "C" void kernel_launch(void* const* d_in, const int* in_sizes, int n_in, void* d_out, int out_size, void* d_ws, size_t ws_size,
                              hipStream_t stream) {
  Params P{};
  const float** pf = (const float**)&P.x;
  for (int i = 0; i < 23; ++i) pf[i] = (const float*)d_in[i];
  P.out = (float*)d_out;
  unsigned char* ws = (unsigned char*)d_ws;
  size_t off = 0;
  auto take = [&](size_t bytes) { unsigned char* p = ws + off; off += (bytes + 255) & ~(size_t)255; return p; };
  const size_t MiB = 1024 * 1024;
  unsigned char* R1 = take(272 * MiB);
  P.act = (bf16_t*)R1;
  P.projb = (bf16_t*)R1;
  P.hbB = (bf16_t*)(R1 + 192 * MiB);
  {
    size_t o = 0;
    auto sub = [&](size_t bytes) { unsigned char* p = R1 + o; o += (bytes + 255) & ~(size_t)255; return p; };
    P.Qa = (bf16_t*)sub((size_t)NTOK * 512 * 2); P.Qb = (bf16_t*)sub((size_t)NTOK * 768 * 2);
    P.Ka = (bf16_t*)sub((size_t)NTOK * 128 * 2); P.Kn = (bf16_t*)sub((size_t)NTOK * 512 * 2); P.Kr = (bf16_t*)sub((size_t)NTOK * 32 * 2);
    P.Vta = (bf16_t*)sub((size_t)NTOK * 128 * 2); P.Vtb = (bf16_t*)sub((size_t)NTOK * 512 * 2);
    P.mix = (bf16_t*)sub((size_t)NTOK * 1024 * 2); P.cqb = (bf16_t*)sub((size_t)NTOK * 256 * 2); P.ckvb = (bf16_t*)sub((size_t)NTOK * 256 * 2);
    o = 0;
    P.Qc = (bf16_t*)sub((size_t)NTOK * 1024 * 2); P.Kc = (bf16_t*)sub((size_t)NTOK * 1024 * 2); P.Vtc = (bf16_t*)sub((size_t)NTOK * 1024 * 2);
  }
  P.hbA = (bf16_t*)take((size_t)NTOK * DM * 2);
  P.pb = (bf16_t*)take((size_t)2 * NTOK * 256 * 2);
  P.ssqA = (float*)take((size_t)NTOK * 16 * 4); P.ssqB = (float*)take((size_t)NTOK * 16 * 4);
  P.ssq_cq = (float*)take((size_t)NTOK * 4 * 4); P.ssq_ckv = (float*)take((size_t)NTOK * 4 * 4);
  P.logf = (float*)take((size_t)NTOK * 16 * 4); P.logc = (float*)take((size_t)NTOK * 16 * 4);
  P.rope = (float*)take((size_t)SEQ * 32 * 4);
  P.barw = (unsigned*)take((size_t)XCD_BAR_WORDS * 4);
  const size_t GU = (size_t)2 * DFF * DM * 2, DW = (size_t)DM * DFF * 2, SQ = (size_t)DM * DM * 2;
  P.w_gu_a0 = (bf16_t*)take(GU); P.w_gu_a1 = (bf16_t*)take(GU); P.w_gu_b0 = (bf16_t*)take(GU); P.w_gu_b1 = (bf16_t*)take(GU);
  P.w_d_a0 = (bf16_t*)take(DW); P.w_d_a1 = (bf16_t*)take(DW); P.w_d_b0 = (bf16_t*)take(DW); P.w_d_b1 = (bf16_t*)take(DW);
  P.w_pg0 = (bf16_t*)take(SQ); P.w_pg1 = (bf16_t*)take(SQ); P.w_pp0 = (bf16_t*)take((size_t)DM * 256 * 2); P.w_pp1 = (bf16_t*)take((size_t)DM * 256 * 2);
  P.w_evin = (bf16_t*)take((size_t)N_EVIN * DM * 2); P.w_uq = (bf16_t*)take((size_t)768 * 256 * 2); P.w_ukv = (bf16_t*)take((size_t)1024 * 256 * 2);
  P.w_evout = (bf16_t*)take(SQ); P.w_odin = (bf16_t*)take((size_t)N_ODIN * DM * 2); P.w_odout = (bf16_t*)take(SQ);
  if (off > ws_size) { fprintf(stderr, "workspace too small: need %zu have %zu\n", off, ws_size); return; }
  static int grid_blocks = 0;
  if (!grid_blocks) {
    int dev = 0, cus = 0, per_cu = 0;
    hipGetDevice(&dev);
    hipDeviceGetAttribute(&cus, hipDeviceAttributeMultiprocessorCount, dev);
    if (hipFuncSetAttribute((const void*)k_mega, hipFuncAttributeMaxDynamicSharedMemorySize, LDS_BYTES) != hipSuccess)
      fprintf(stderr, "hipFuncSetAttribute(MaxDynamicSharedMemorySize) failed\n");
    hipOccupancyMaxActiveBlocksPerMultiprocessor(&per_cu, k_mega, NTHREADS, LDS_BYTES);
    if (per_cu < 1) fprintf(stderr, "occupancy query says %d blocks/CU\n", per_cu);
    grid_blocks = cus & ~7;
    (void)hipGetLastError();
  }
  if (hipMemsetAsync(P.barw, 0, (size_t)XCD_BAR_WORDS * 4, stream) != hipSuccess) { fprintf(stderr, "memset of barrier words failed\n"); return; }
  void* args[] = {&P};
  hipError_t e = hipLaunchCooperativeKernel((void*)k_mega, dim3(grid_blocks), dim3(NTHREADS), args, LDS_BYTES, stream);
  if (e != hipSuccess) fprintf(stderr, "cooperative launch failed: %s (grid %d)\n", hipGetErrorString(e), grid_blocks);
}
```

```cpp
#include <hip/hip_runtime.h>
#include <hip/hip_cooperative_groups.h>
#include <stdint.h>
#include <stdio.h>
namespace cg = cooperative_groups;

__device__ __forceinline__ int tid_fresh() { int t = threadIdx.x; asm volatile("" : "+v"(t)); return t; }
namespace pg8 {
#define PG8_LAS __attribute__((address_space(3)))
typedef unsigned short bf16_t;
typedef short bf16x8 __attribute__((ext_vector_type(8)));
typedef float f32x4 __attribute__((ext_vector_type(4)));
typedef unsigned u32x4 __attribute__((ext_vector_type(4)));
constexpr int BM = 256, BK = 64, HALF = 128, HTB = HALF * BK * 2  , STAGE_BYTES = 8 * HTB, NXCD = 8, WGM = 8;

__host__ __device__ __forceinline__ int lds_byte(int r, int c) { const int st = (r >> 4) * 2 + (c >> 5), rr = r & 15, cc = c & 31, ob = rr * 64 + cc * 2; return st * 1024 + (ob ^ (((ob >> 9) & 1) << 5)); }
__host__ __device__ __forceinline__ void stage_rc(int b, int& R, int& C) { const int st = b / 1024, sb = b % 1024, swz = sb ^ (((sb >> 9) & 1) << 5); R = (st >> 1) * 16 + swz / 64; C = (st & 1) * 32 + (swz % 64) / 2; }
__host__ __device__ __forceinline__ int perm32(int rho) { const int n = rho >> 4, i = rho & 15; return 8 * (i >> 2) + 4 * n + (i & 3); }

struct Unit { int pm, pn; };
struct Gemm { const bf16_t* A; const bf16_t* Bt; int M, N, K; };

struct StaticOrder {
    int nM, nN, nwg, G, c;
    __host__ __device__ void init(int M, int N, int G_, int c_) { nM = M / BM; nN = N / BM; nwg = nM * nN; G = G_; c = c_; }
    __host__ __device__ bool next(int i, Unit& u) const {
        const long L = (long)i * G + c; if (L >= nwg) return false;
        int wgid = (int)L; { const int q = nwg / NXCD, r = nwg % NXCD, xcd = wgid % NXCD, off = wgid / NXCD; wgid = (xcd < r ? xcd * (q + 1) : r * (q + 1) + (xcd - r) * q) + off; }
        const int nig = WGM * nN, gid = wgid / nig, fm = gid * WGM, gsz = (nM - fm) < WGM ? (nM - fm) : WGM;
        u.pm = fm + ((wgid % nig) % gsz); u.pn = (wgid % nig) / gsz; return true;
    }
    __device__ __forceinline__ void a_ready(const Unit&) const {}
    __device__ __forceinline__ void done(const Unit&) const {}
};
template <class Epi, class Sched, bool ALIGN_EPI = false, bool SP2 = false>
__device__ __forceinline__ void gemm_phase(PG8_LAS unsigned char* lds, const Gemm g, const Sched& S, const Epi& E) {
    const int tid = tid_fresh(), wid = __builtin_amdgcn_readfirstlane(tid >> 6), lane = tid & 63, wr = wid >> 2, wc = wid & 3, fr = lane & 15, fq = lane >> 4;
    const int K = g.K, nt = K / BK;
    unsigned voffA[2], voffB[2];
#pragma unroll
    for (int i = 0; i < 2; ++i) { int R, C; stage_rc(tid * 16 + i * 8192, R, C); const int Rb = Epi::PERM ? ((R & ~31) + perm32(R & 31)) : R;
        voffA[i] = (unsigned)(R * K + C) * 2u; voffB[i] = (unsigned)(Rb * K + C) * 2u; }
    const size_t kstep = (size_t)(BK * 2);
    const size_t hstep = (size_t)HALF * K * 2;
    const size_t tstep = 2 * hstep;
    const unsigned ldsw = (unsigned)wid * 1024u;
    const int aoff = lds_byte(wr * 64 + fr, fq * 8), boff = lds_byte(wc * 32 + fr, fq * 8);
#define PG8_SA(b, h) (((b) * 2 + (h)) * HTB)
#define PG8_SB(b, h) ((4 + (b) * 2 + (h)) * HTB)
#define PG8_STAGE(bufoff, gbase, voff) do { _Pragma("unroll") for (int _i = 0; _i < 2; ++_i) \
        __builtin_amdgcn_global_load_lds((const unsigned*)((const char*)(gbase) + (voff)[_i]), (PG8_LAS unsigned*)(lds + (bufoff) + ldsw + _i * 8192), 16, 0, 0); } while (0)
#define PG8_LDA(dst, b, h) do { _Pragma("unroll") for (int m = 0; m < 4; ++m) _Pragma("unroll") for (int k = 0; k < 2; ++k) dst[m][k] = *(const PG8_LAS bf16x8*)(lds + PG8_SA(b, h) + aoff + m * 2048 + k * 1024); } while (0)
#define PG8_LDB(dst, b, h) do { _Pragma("unroll") for (int n = 0; n < 2; ++n) _Pragma("unroll") for (int k = 0; k < 2; ++k) dst[n][k] = *(const PG8_LAS bf16x8*)(lds + PG8_SB(b, h) + boff + n * 2048 + k * 1024); } while (0)
#define PG8_MMA(ai, bj, At, Bt) do { __builtin_amdgcn_s_setprio(1); _Pragma("unroll") for (int m = 0; m < 4; ++m) _Pragma("unroll") for (int n = 0; n < 2; ++n) _Pragma("unroll") for (int k = 0; k < 2; ++k) \
        acc[ai][bj][m][n] = __builtin_amdgcn_mfma_f32_16x16x32_bf16(Bt[n][k], At[m][k], acc[ai][bj][m][n], 0, 0, 0); __builtin_amdgcn_s_setprio(0); } while (0)
#define PG8_WAIT_V(n) asm volatile("s_waitcnt vmcnt(" #n ")" ::: "memory")
#define PG8_WAIT_L(n) asm volatile("s_waitcnt lgkmcnt(" #n ")" ::: "memory")
#define PG8_BAR __builtin_amdgcn_s_barrier()
#define PG8_SCHED __builtin_amdgcn_sched_barrier(0)
    Unit cur, nxt; int ui = 0;
    if (!S.next(0, cur)) return;
    f32x4 acc[2][2][4][2];
#pragma unroll
    for (int a = 0; a < 2; ++a)
#pragma unroll
        for (int b = 0; b < 2; ++b)
#pragma unroll
            for (int m = 0; m < 4; ++m)
#pragma unroll
                for (int n = 0; n < 2; ++n) acc[a][b][m][n] = (f32x4){0.f, 0.f, 0.f, 0.f};
    bf16x8 At[4][2], B0[2][2], B1[2][2];
    const char* cA = (const char*)g.A + (size_t)cur.pm * tstep; const char* cB = (const char*)g.Bt + (size_t)cur.pn * tstep;
    S.a_ready(cur);
    if constexpr (SP2) {
        PG8_STAGE(PG8_SB(0, 0), cB, voffB); PG8_STAGE(PG8_SB(0, 1), cB + hstep, voffB); PG8_STAGE(PG8_SA(0, 0), cA, voffA); PG8_STAGE(PG8_SA(0, 1), cA + hstep, voffA);
        if (wr == 1) PG8_BAR;
        PG8_WAIT_V(2); PG8_BAR;
        PG8_STAGE(PG8_SB(1, 0), cB + kstep, voffB); PG8_STAGE(PG8_SA(1, 0), cA + kstep, voffA); PG8_STAGE(PG8_SB(1, 1), cB + hstep + kstep, voffB);
        PG8_WAIT_V(6); PG8_BAR;
    } else {
        PG8_STAGE(PG8_SB(0, 0), cB, voffB); PG8_STAGE(PG8_SA(0, 0), cA, voffA); PG8_STAGE(PG8_SB(0, 1), cB + hstep, voffB); PG8_STAGE(PG8_SA(0, 1), cA + hstep, voffA);
        if (wr == 1) PG8_BAR;
        PG8_WAIT_V(4); PG8_BAR;
        PG8_STAGE(PG8_SB(1, 0), cB + kstep, voffB); PG8_STAGE(PG8_SA(1, 0), cA + kstep, voffA); PG8_STAGE(PG8_SB(1, 1), cB + hstep + kstep, voffB);
        PG8_WAIT_V(6); PG8_BAR;
    }
    for (;;) {
        const bool has_next = S.next(ui + 1, nxt);
        const char* nA = has_next ? (const char*)g.A + (size_t)nxt.pm * tstep : cA; const char* nB = has_next ? (const char*)g.Bt + (size_t)nxt.pn * tstep : cB;
        for (int t = 0; t < nt; t += 2) {
            const bool last = (t == nt - 2);
            const char* a1 = cA + (size_t)(t + 1) * kstep;
            const char* a2 = last ? nA : cA + (size_t)(t + 2) * kstep; const char* b2 = last ? nB : cB + (size_t)(t + 2) * kstep;
            const char* a3 = a2 + kstep; const char* b3 = b2 + kstep;
            if (last && has_next) S.a_ready(nxt);
            if constexpr (SP2) {
            PG8_LDB(B0, 0, 0); PG8_LDB(B1, 0, 1); PG8_SCHED; PG8_LDA(At, 0, 0); PG8_STAGE(PG8_SA(1, 1), a1 + hstep, voffA);
            PG8_WAIT_V(8); PG8_WAIT_L(0); PG8_BAR; PG8_MMA(0, 0, At, B0); PG8_MMA(0, 1, At, B1); PG8_BAR; PG8_SCHED;
            PG8_LDA(At, 0, 1); PG8_STAGE(PG8_SB(0, 0), b2, voffB); PG8_STAGE(PG8_SB(0, 1), b2 + hstep, voffB); PG8_STAGE(PG8_SA(0, 0), a2, voffA);
            PG8_WAIT_V(8); PG8_WAIT_L(0); PG8_BAR; PG8_MMA(1, 0, At, B0); PG8_MMA(1, 1, At, B1); PG8_BAR; PG8_SCHED;
            PG8_LDB(B0, 1, 0); PG8_LDB(B1, 1, 1); PG8_SCHED; PG8_LDA(At, 1, 0); PG8_STAGE(PG8_SA(0, 1), a2 + hstep, voffA);
            PG8_WAIT_V(8); PG8_WAIT_L(0); PG8_BAR; PG8_MMA(0, 0, At, B0); PG8_MMA(0, 1, At, B1); PG8_BAR; PG8_SCHED;
            PG8_LDA(At, 1, 1); PG8_STAGE(PG8_SB(1, 0), b3, voffB); PG8_STAGE(PG8_SB(1, 1), b3 + hstep, voffB); PG8_STAGE(PG8_SA(1, 0), a3, voffA);
            PG8_WAIT_V(8); PG8_WAIT_L(0); PG8_BAR; PG8_MMA(1, 0, At, B0); PG8_MMA(1, 1, At, B1); PG8_BAR; PG8_SCHED;
            } else {
            PG8_LDB(B0, 0, 0); PG8_SCHED; PG8_LDA(At, 0, 0); PG8_STAGE(PG8_SA(1, 1), a1 + hstep, voffA);
            PG8_WAIT_L(8); PG8_BAR; PG8_WAIT_L(0); PG8_MMA(0, 0, At, B0); PG8_BAR; PG8_SCHED;
            PG8_LDB(B1, 0, 1); PG8_STAGE(PG8_SB(0, 0), b2, voffB);
            PG8_BAR; PG8_WAIT_L(0); PG8_MMA(0, 1, At, B1); PG8_BAR;
            PG8_LDA(At, 0, 1); PG8_STAGE(PG8_SA(0, 0), a2, voffA);
            PG8_BAR; PG8_WAIT_L(0); PG8_MMA(1, 0, At, B0); PG8_BAR; PG8_SCHED;
            PG8_STAGE(PG8_SB(0, 1), b2 + hstep, voffB);
            PG8_WAIT_V(6); PG8_BAR; PG8_MMA(1, 1, At, B1); PG8_BAR;
            PG8_LDB(B0, 1, 0); PG8_SCHED; PG8_LDA(At, 1, 0); PG8_STAGE(PG8_SA(0, 1), a2 + hstep, voffA);
            PG8_WAIT_L(8); PG8_BAR; PG8_WAIT_L(0); PG8_MMA(0, 0, At, B0); PG8_BAR; PG8_SCHED;
            PG8_LDB(B1, 1, 1); PG8_STAGE(PG8_SB(1, 0), b3, voffB);
            PG8_BAR; PG8_WAIT_L(0); PG8_MMA(0, 1, At, B1); PG8_BAR;
            PG8_LDA(At, 1, 1); PG8_STAGE(PG8_SA(1, 0), a3, voffA);
            PG8_BAR; PG8_WAIT_L(0); PG8_MMA(1, 0, At, B0); PG8_BAR; PG8_SCHED;
            PG8_STAGE(PG8_SB(1, 1), b3 + hstep, voffB);
            PG8_WAIT_V(6); PG8_BAR; PG8_MMA(1, 1, At, B1); PG8_BAR;
            }
        }
        if constexpr (ALIGN_EPI) { if (wr == 0) PG8_BAR; }
        if constexpr (!Epi::AFTER_DRAIN) { E(acc, cur, wr, wc, fr, fq); S.done(cur); }
        if (!has_next) break;
#pragma unroll
        for (int a = 0; a < 2; ++a)
#pragma unroll
            for (int b = 0; b < 2; ++b)
#pragma unroll
                for (int m = 0; m < 4; ++m)
#pragma unroll
                    for (int n = 0; n < 2; ++n) acc[a][b][m][n] = (f32x4){0.f, 0.f, 0.f, 0.f};
        cur = nxt; cA = nA; cB = nB; ++ui;
        if constexpr (ALIGN_EPI) { if (wr == 1) PG8_BAR; }
    }
    PG8_WAIT_V(0);
    if constexpr (!ALIGN_EPI) { if (wr == 0) PG8_BAR; }
    PG8_BAR;
    if constexpr (Epi::AFTER_DRAIN) { E.fused(acc, cur, wr, wc, fr, fq, lds, wid, lane); S.done(cur); }
#undef PG8_SA
#undef PG8_SB
#undef PG8_STAGE
#undef PG8_LDA
#undef PG8_LDB
#undef PG8_MMA
#undef PG8_WAIT_V
#undef PG8_WAIT_L
#undef PG8_BAR
#undef PG8_SCHED
}
}

typedef unsigned short bf16_t;
typedef short bf16x8 __attribute__((ext_vector_type(8)));
typedef float f32x16 __attribute__((ext_vector_type(16)));
typedef float f32x4 __attribute__((ext_vector_type(4)));
typedef unsigned u32x4 __attribute__((ext_vector_type(4)));
typedef unsigned u32x2 __attribute__((ext_vector_type(2)));
#define LAS __attribute__((address_space(3)))
#define GAS __attribute__((address_space(1)))

#define SEQ 4096
#define NTOK 32768
#define DM 1024
#define DFF 2816
#define LOG2E 1.4426950408889634f
#define RMS_EPS 1e-6f
#define NTHREADS 512
#define LDS_BYTES (131072 + 16)
#define N_EVIN 1536
#define N_ODIN 3328

struct Params {
  const float *x, *p, *ffa_norm, *ffa_gu, *ffa_d, *mix_norm, *ffb_norm, *ffb_gu, *ffb_d, *ple_norm, *ple_g, *ple_p;
  const float *ev_in, *ev_sinks, *ev_cqn, *ev_uq, *ev_ckvn, *ev_ukv, *ev_out, *od_in, *od_bf, *od_out, *final_norm;
  float* out;
  bf16_t *hbA, *hbB, *pb, *act, *projb;
  float *ssqA, *ssqB, *ssq_cq, *ssq_ckv, *logf, *logc, *rope;
  unsigned* barw;
  bf16_t *w_gu_a0, *w_gu_a1, *w_gu_b0, *w_gu_b1, *w_d_a0, *w_d_a1, *w_d_b0, *w_d_b1;
  bf16_t *w_pg0, *w_pg1, *w_pp0, *w_pp1, *w_evin, *w_uq, *w_ukv, *w_evout, *w_odin, *w_odout;
  bf16_t *Qa, *Qb, *Ka, *Kn, *Kr, *Vta, *Vtb, *mix, *cqb, *ckvb;
  bf16_t *Qc, *Kc, *Vtc;
};

typedef __bf16 bf16x2_t __attribute__((ext_vector_type(2)));
typedef float f32x2_t __attribute__((ext_vector_type(2)));
__device__ __forceinline__ unsigned pk_bf16(float lo, float hi) {
  f32x2_t v = {lo, hi};
  bf16x2_t b = __builtin_convertvector(v, bf16x2_t);
  return __builtin_bit_cast(unsigned, b);
}
__device__ __forceinline__ bf16_t f2bf(float f) { return (bf16_t)(pk_bf16(f, 0.f) & 0xffffu); }
__device__ __forceinline__ float fast_exp2(float x) { return __builtin_amdgcn_exp2f(x); }
__device__ __forceinline__ float fast_rcp(float x) { return __builtin_amdgcn_rcpf(x); }
__device__ __forceinline__ float sigmoidf_fast(float z) { return fast_rcp(1.f + fast_exp2(-z * LOG2E)); }
__device__ __forceinline__ int perm_s(int s) { return (s & ~12) | ((s & 4) << 1) | ((s & 8) >> 1); }
__device__ __forceinline__ float bf_lo(unsigned w) { return __uint_as_float(w << 16); }
__device__ __forceinline__ float bf_hi(unsigned w) { return __uint_as_float(w & 0xffff0000u); }

__device__ __forceinline__ const Params& kparams() {
  const Params* q = (const Params*)__builtin_amdgcn_kernarg_segment_ptr();
  asm volatile("" : "+s"(q));
  return *q;
}
#define ACC_T const f32x4 (&acc)[2][2][4][2]
using pg8::Unit;
__device__ __forceinline__ int erow(const Unit& u, int ai, int wr, int m, int fr) { return u.pm * 256 + ai * 128 + wr * 64 + m * 16 + fr; }

template <int NP>
__device__ __forceinline__ void rows_rstd(const float* ssq, float invn, const Unit& u, int wr, int fr, int fq, float (&rs)[2][4]) {
#pragma unroll
  for (int ai = 0; ai < 2; ++ai)
#pragma unroll
    for (int m = 0; m < 4; ++m) {
      const int row = erow(u, ai, wr, m, fr);
      float s;
      if (NP == 16) {
        const f32x4 v = *(GAS const f32x4*)(ssq + (size_t)row * 16 + 4 * fq);
        s = (v[0] + v[1]) + (v[2] + v[3]);
        s += __shfl_xor(s, 16); s += __shfl_xor(s, 32);
      } else {
        const f32x4 v = *(GAS const f32x4*)(ssq + (size_t)row * 4);
        s = (v[0] + v[1]) + (v[2] + v[3]);
      }
      rs[ai][m] = rsqrtf(s * invn + RMS_EPS);
    }
}
template <int NP>
__device__ __forceinline__ float row_rstd(const float* ssq, float invn, int row, int fq) {
  float s;
  if (NP == 16) {
    const f32x4 v = *(GAS const f32x4*)(ssq + (size_t)row * 16 + 4 * fq);
    s = (v[0] + v[1]) + (v[2] + v[3]);
    s += __shfl_xor(s, 16); s += __shfl_xor(s, 32);
  } else {
    const f32x4 v = *(GAS const f32x4*)(ssq + (size_t)row * 4);
    s = (v[0] + v[1]) + (v[2] + v[3]);
  }
  return rsqrtf(s * invn + RMS_EPS);
}
#define ROW_FENCE() asm volatile("" ::: "memory")
__device__ __forceinline__ u32x4 pack8(const f32x4& a, const f32x4& b, float sc) {
  u32x4 w; w.x = pk_bf16(a[0] * sc, a[1] * sc); w.y = pk_bf16(a[2] * sc, a[3] * sc); w.z = pk_bf16(b[0] * sc, b[1] * sc); w.w = pk_bf16(b[2] * sc, b[3] * sc); return w;
}
__device__ __forceinline__ void store_vt8(bf16_t* base_  , const f32x4& a, const f32x4& b, float sc) {
  GAS bf16_t* base = (GAS bf16_t*)base_;
#pragma unroll
  for (int j = 0; j < 4; ++j) { base[(size_t)j * SEQ] = f2bf(a[j] * sc); base[(size_t)(4 + j) * SEQ] = f2bf(b[j] * sc); }
}
__device__ __forceinline__ u32x4 rope8(const f32x4& a, const f32x4& b, float sc, const float* tab  , int fq) {
  float v[8], p[8], o[8];
#pragma unroll
  for (int j = 0; j < 4; ++j) { v[j] = a[j] * sc; v[4 + j] = b[j] * sc; }
#pragma unroll
  for (int j = 0; j < 8; ++j) p[j] = __shfl_xor(v[j], 32);
  const f32x4 c0 = *(GAS const f32x4*)(tab + 8 * (fq & 1)), c1 = *(GAS const f32x4*)(tab + 8 * (fq & 1) + 4);
  const f32x4 s0 = *(GAS const f32x4*)(tab + 16 + 8 * (fq & 1)), s1 = *(GAS const f32x4*)(tab + 16 + 8 * (fq & 1) + 4);
#pragma unroll
  for (int j = 0; j < 8; ++j) {
    const float cc = j < 4 ? c0[j & 3] : c1[j & 3], sn = j < 4 ? s0[j & 3] : s1[j & 3];
    o[j] = (fq < 2) ? (v[j] * cc - p[j] * sn) : (p[j] * sn + v[j] * cc);
  }
  u32x4 w; w.x = pk_bf16(o[0], o[1]); w.y = pk_bf16(o[2], o[3]); w.z = pk_bf16(o[4], o[5]); w.w = pk_bf16(o[6], o[7]); return w;
}

struct EpiGU {
  static constexpr bool PERM = true, AFTER_DRAIN = false;
  const float* ssq; bf16_t* act;
  __device__ __forceinline__ void operator()(ACC_T, const Unit& u, int wr, int wc, int fr, int fq) const {
    float rs[2][4]; rows_rstd<16>(ssq, 1.0f / DM, u, wr, fr, fq, rs);
#pragma unroll
    for (int ai = 0; ai < 2; ++ai)
#pragma unroll
      for (int m = 0; m < 4; ++m) {
        const int row = erow(u, ai, wr, m, fr); const float r = rs[ai][m];
        float v[8];
#pragma unroll
        for (int n = 0; n < 2; ++n)
#pragma unroll
          for (int j = 0; j < 4; ++j) {
            const float g = acc[ai][0][m][n][j] * r, uu = acc[ai][1][m][n][j] * r;
            v[4 * n + j] = g * sigmoidf_fast(g) * uu;
          }
        u32x4 w; w.x = pk_bf16(v[0], v[1]); w.y = pk_bf16(v[2], v[3]); w.z = pk_bf16(v[4], v[5]); w.w = pk_bf16(v[6], v[7]);
        *(GAS u32x4*)(act + (size_t)row * DFF + 128 * u.pn + 32 * wc + 8 * fq) = w;
        ROW_FENCE();
      }
  }
};

struct EpiBf16Plain {
  static constexpr bool PERM = true, AFTER_DRAIN = false;
  bf16_t* o; int ld;
  __device__ __forceinline__ void operator()(ACC_T, const Unit& u, int wr, int wc, int fr, int fq) const {
#pragma unroll
    for (int ai = 0; ai < 2; ++ai)
#pragma unroll
      for (int m = 0; m < 4; ++m) {
        const int row = erow(u, ai, wr, m, fr);
#pragma unroll
        for (int bj = 0; bj < 2; ++bj)
          *(GAS u32x4*)(o + (size_t)row * ld + 256 * u.pn + 128 * bj + 32 * wc + 8 * fq) = pack8(acc[ai][bj][m][0], acc[ai][bj][m][1], 1.f);
        ROW_FENCE();
      }
  }
};

template <bool GATED, bool XIN>
struct EpiRes {
  static constexpr bool PERM = true, AFTER_DRAIN = false;
  const float* xin; const bf16_t* hres; bf16_t* hb; float* ssq_out; float scale; const float* ssq_in; const bf16_t* projb;
  __device__ __forceinline__ void operator()(ACC_T, const Unit& u, int wr, int wc, int fr, int fq) const {
    float rs[2][4];
    if (GATED) rows_rstd<16>(ssq_in, 1.0f / DM, u, wr, fr, fq, rs);
    const int cbase = 256 * u.pn + 32 * wc + 8 * fq;
    constexpr int NB = GATED ? 4 : 8;
    float ss = 0.f;
#pragma unroll
    for (int b0 = 0; b0 < 16; b0 += NB) {
      u32x4 hq[NB], pq[GATED ? NB : 1];
#pragma unroll
      for (int k = 0; k < NB; ++k) {
        const int st = b0 + k, ri = st >> 1;
        const size_t off = (size_t)erow(u, ri >> 2, wr, ri & 3, fr) * DM + cbase + 128 * (st & 1);
        hq[k] = *(GAS const u32x4*)(hres + off);
        if (GATED) pq[k] = *(GAS const u32x4*)(projb + off);
      }
#pragma unroll
      for (int k = 0; k < NB; ++k) {
        const int st = b0 + k, ri = st >> 1, bj = st & 1, ai = ri >> 2, m = ri & 3;
        const int row = erow(u, ai, wr, m, fr);
        const u32x4 hnx = hq[k];
        f32x4 h0, h1;
        h0[0] = bf_lo(hnx.x); h0[1] = bf_hi(hnx.x); h0[2] = bf_lo(hnx.y); h0[3] = bf_hi(hnx.y);
        h1[0] = bf_lo(hnx.z); h1[1] = bf_hi(hnx.z); h1[2] = bf_lo(hnx.w); h1[3] = bf_hi(hnx.w);
        const float rg = GATED ? rs[ai][m] : 0.f;
        const size_t off = (size_t)row * DM + cbase + 128 * bj;
        float pr[8];
        if (GATED) {
          const u32x4 pw = pq[k];
          pr[0] = bf_lo(pw.x); pr[1] = bf_hi(pw.x); pr[2] = bf_lo(pw.y); pr[3] = bf_hi(pw.y);
          pr[4] = bf_lo(pw.z); pr[5] = bf_hi(pw.z); pr[6] = bf_lo(pw.w); pr[7] = bf_hi(pw.w);
        }
        f32x4 v0, v1;
#pragma unroll
        for (int j = 0; j < 4; ++j) {
          const float a0 = acc[ai][bj][m][0][j], a1 = acc[ai][bj][m][1][j];
          const float d0 = GATED ? sigmoidf_fast(a0 * rg) * pr[j] : scale * a0;
          const float d1 = GATED ? sigmoidf_fast(a1 * rg) * pr[4 + j] : scale * a1;
          v0[j] = h0[j] + d0; v1[j] = h1[j] + d1;
          ss += v0[j] * v0[j] + v1[j] * v1[j];
        }
        *(GAS u32x4*)(hb + off) = pack8(v0, v1, 1.f);
        if (bj == 1) {
          ss += __shfl_xor(ss, 16); ss += __shfl_xor(ss, 32);
          if (fq == 0) ((GAS float*)ssq_out)[(size_t)row * 16 + 4 * u.pn + wc] = ss;
          ss = 0.f;
        }
      }
    }
  }
};

struct EpiInEven {
  static constexpr bool PERM = true, AFTER_DRAIN = false;
  int dummy;
  __device__ __forceinline__ void operator()(ACC_T, const Unit& u, int wr, int wc, int fr, int fq) const {
    if (u.pn == 5 && wc != 0) return;
    const Params& P = kparams();
    const float *ssq = P.ssqA, *rope = P.rope; bf16_t *Qa = P.Qa, *Ka = P.Ka, *Vta = P.Vta, *cqb = P.cqb, *ckvb = P.ckvb, *Kr = P.Kr; float *ssq_cq = P.ssq_cq, *ssq_ckv = P.ssq_ckv;
    float rs[2][4]; rows_rstd<16>(ssq, 1.0f / DM, u, wr, fr, fq, rs);
#pragma unroll
    for (int ai = 0; ai < 2; ++ai)
#pragma unroll
      for (int m = 0; m < 4; ++m) {
        const int row = erow(u, ai, wr, m, fr), b = row >> 12, s = row & (SEQ - 1); const float r = rs[ai][m];
        const int c8 = 32 * wc + 8 * fq;
        if (u.pn < 2) {
#pragma unroll
          for (int bj = 0; bj < 2; ++bj)
            *(GAS u32x4*)(Qa + (size_t)row * 512 + 256 * u.pn + 128 * bj + c8) = pack8(acc[ai][bj][m][0], acc[ai][bj][m][1], r * (0.125f * LOG2E));
        } else if (u.pn == 2) {
          *(GAS u32x4*)(Ka + (size_t)row * 128 + c8) = pack8(acc[ai][0][m][0], acc[ai][0][m][1], r);
          store_vt8(Vta + ((size_t)(b * 2 + (c8 >> 6)) * 64 + (c8 & 63)) * SEQ + perm_s(s), acc[ai][1][m][0], acc[ai][1][m][1], r);
        } else if (u.pn == 3 || u.pn == 4) {
          bf16_t* o = (u.pn == 3 ? cqb : ckvb) + (size_t)row * 256 + c8;
          float ss = 0.f;
#pragma unroll
          for (int bj = 0; bj < 2; ++bj) {
            *(GAS u32x4*)(o + 128 * bj) = pack8(acc[ai][bj][m][0], acc[ai][bj][m][1], r);
#pragma unroll
            for (int j = 0; j < 4; ++j) { const float a0 = acc[ai][bj][m][0][j] * r, a1 = acc[ai][bj][m][1][j] * r; ss += a0 * a0 + a1 * a1; }
          }
          ss += __shfl_xor(ss, 16); ss += __shfl_xor(ss, 32);
          if (fq == 0) ((GAS float*)(u.pn == 3 ? ssq_cq : ssq_ckv))[(size_t)row * 4 + wc] = ss;
        } else {
          *(GAS u32x4*)(Kr + (size_t)row * 32 + 8 * fq) = rope8(acc[ai][0][m][0], acc[ai][0][m][1], r, rope + (size_t)s * 32, fq);
        }
        ROW_FENCE();
      }
  }
};

struct EpiUQ {
  static constexpr bool PERM = true, AFTER_DRAIN = false;
  const float *ssq_cq, *rope; bf16_t* Qb;
  __device__ __forceinline__ void operator()(ACC_T, const Unit& u, int wr, int wc, int fr, int fq) const {
    const float qs = 0.10206207261596577f * LOG2E;
    float rs[2][4]; rows_rstd<4>(ssq_cq, 1.0f / 256, u, wr, fr, fq, rs);
#pragma unroll
    for (int ai = 0; ai < 2; ++ai)
#pragma unroll
      for (int m = 0; m < 4; ++m) {
        const int row = erow(u, ai, wr, m, fr), s = row & (SEQ - 1); const float r = rs[ai][m] * qs;
#pragma unroll
        for (int bj = 0; bj < 2; ++bj) {
          const int F = 8 * u.pn + 4 * bj + wc;
          bf16_t* o = Qb + (size_t)row * 768 + 32 * F + 8 * fq;
          if (F % 3 != 2) *(GAS u32x4*)o = pack8(acc[ai][bj][m][0], acc[ai][bj][m][1], r);
          else *(GAS u32x4*)o = rope8(acc[ai][bj][m][0], acc[ai][bj][m][1], r, rope + (size_t)s * 32, fq);
        }
        ROW_FENCE();
      }
  }
};

struct EpiUKV {
  static constexpr bool PERM = true, AFTER_DRAIN = false;
  const float* ssq_ckv; bf16_t *Kn, *Vtb;
  __device__ __forceinline__ void operator()(ACC_T, const Unit& u, int wr, int wc, int fr, int fq) const {
    float rs[2][4]; rows_rstd<4>(ssq_ckv, 1.0f / 128, u, wr, fr, fq, rs);
#pragma unroll
    for (int ai = 0; ai < 2; ++ai)
#pragma unroll
      for (int m = 0; m < 4; ++m) {
        const int row = erow(u, ai, wr, m, fr), b = row >> 12, s = row & (SEQ - 1); const float r = rs[ai][m];
#pragma unroll
        for (int bj = 0; bj < 2; ++bj) {
          const int head = 2 * u.pn + bj, within = 32 * wc + 8 * fq;
          if (wc < 2) *(GAS u32x4*)(Kn + (size_t)row * 512 + head * 64 + within) = pack8(acc[ai][bj][m][0], acc[ai][bj][m][1], r);
          else store_vt8(Vtb + ((size_t)(b * 8 + head) * 64 + (within - 64)) * SEQ + perm_s(s), acc[ai][bj][m][0], acc[ai][bj][m][1], r);
        }
        ROW_FENCE();
      }
  }
};

struct EpiInOdd {
  static constexpr bool PERM = true, AFTER_DRAIN = false;
  int dummy;
  __device__ __forceinline__ void operator()(ACC_T, const Unit& u, int wr, int wc, int fr, int fq) const {
    if (u.pn == 12 && wc != 0) return;
    const Params& P = kparams();
    const float *ssq = P.ssqA, *bfp = P.od_bf; bf16_t *Qc = P.Qc, *Kc = P.Kc, *Vtc = P.Vtc; float* logf = P.logf;
    float rs[2][4]; rows_rstd<16>(ssq, 1.0f / DM, u, wr, fr, fq, rs);
#pragma unroll
    for (int ai = 0; ai < 2; ++ai)
#pragma unroll
      for (int m = 0; m < 4; ++m) {
        const int row = erow(u, ai, wr, m, fr), b = row >> 12, s = row & (SEQ - 1); const float r = rs[ai][m];
        if (u.pn < 8) {
          bf16_t* o = (u.pn < 4 ? Qc : Kc) + (size_t)row * 1024 + 256 * (u.pn & 3) + 32 * wc + 8 * fq;
          const float sc = u.pn < 4 ? r * (0.125f * LOG2E) : r;
#pragma unroll
          for (int bj = 0; bj < 2; ++bj) *(GAS u32x4*)(o + 128 * bj) = pack8(acc[ai][bj][m][0], acc[ai][bj][m][1], sc);
        } else if (u.pn < 12) {
#pragma unroll
          for (int bj = 0; bj < 2; ++bj) {
            const int c = 256 * (u.pn - 8) + 128 * bj + 32 * wc + 8 * fq;
            store_vt8(Vtc + ((size_t)(b * 16 + (c >> 6)) * 64 + (c & 63)) * SEQ + perm_s(s), acc[ai][bj][m][0], acc[ai][bj][m][1], r);
          }
        } else if (fq < 2) {
          f32x4 o0, o1;
          const f32x4 b0 = *(GAS const f32x4*)(bfp + 8 * fq), b1 = *(GAS const f32x4*)(bfp + 8 * fq + 4);
#pragma unroll
          for (int j = 0; j < 4; ++j) {
            const float x0 = acc[ai][0][m][0][j] * r + b0[j], x1 = acc[ai][0][m][1][j] * r + b1[j];
            o0[j] = fminf(x0, 0.f) - log1pf(__expf(-fabsf(x0)));
            o1[j] = fminf(x1, 0.f) - log1pf(__expf(-fabsf(x1)));
          }
          *(GAS f32x4*)(logf + (size_t)row * 16 + 8 * fq) = o0; *(GAS f32x4*)(logf + (size_t)row * 16 + 8 * fq + 4) = o1;
        }
        ROW_FENCE();
      }
  }
};

template <bool ALIGN = true, class Epi>
__device__ __forceinline__ void run_gemm(LAS unsigned char* lds, const bf16_t* A, const bf16_t* Bt, int N, int K, const Epi& E) {
  asm volatile("" : "+s"(N), "+s"(K));
  pg8::Gemm g{A, Bt, NTOK, N, K};
  pg8::StaticOrder S; S.init(NTOK, N, (int)gridDim.x, (int)blockIdx.x);
  pg8::gemm_phase<Epi, pg8::StaticOrder, ALIGN, true>(lds, g, S, E);
}

__device__ __forceinline__ void store_frag_bf16(bf16_t* base, const f32x16& a, float sc, int hi) {
#pragma unroll
  for (int g = 0; g < 4; ++g) {
    u32x2 w; w.x = pk_bf16(a[4 * g] * sc, a[4 * g + 1] * sc); w.y = pk_bf16(a[4 * g + 2] * sc, a[4 * g + 3] * sc);
    *(GAS u32x2*)(base + 8 * g + 4 * hi) = w;
  }
}
template <int MODE>
__device__ __forceinline__ void attn_unit(const Params& P, int b, int h, int qb, unsigned char* smem) {
  const int tid = tid_fresh(), lane = tid & 63, w = tid >> 6, r = lane & 31, hi = lane >> 5;
  constexpr int NKS = (MODE == 0) ? 6 : 4;
  const bf16_t *Q, *K, *Kr = nullptr, *Vt; bf16_t* O; int ldq, ldk; const float* cb = nullptr;
  float slope2 = 0.f, m_run = -1e30f, l_run = 0.f;
  if (MODE == 0) {
    Q = P.Qb + (size_t)b * SEQ * 768 + h * 96; ldq = 768; K = P.Kn + (size_t)b * SEQ * 512 + h * 64; ldk = 512;
    Kr = P.Kr + (size_t)b * SEQ * 32; Vt = P.Vtb + (size_t)(b * 8 + h) * 64 * SEQ; O = P.mix + (size_t)b * SEQ * 1024 + 512 + h * 64;
  } else if (MODE == 1) {
    Q = P.Qc + (size_t)b * SEQ * 1024 + h * 64; ldq = 1024; K = P.Kc + (size_t)b * SEQ * 1024 + h * 64; ldk = 1024;
    Vt = P.Vtc + (size_t)(b * 16 + h) * 64 * SEQ; O = P.Qc + (size_t)b * SEQ * 1024 + h * 64; cb = P.logc + (size_t)(b * 16 + h) * SEQ;
  } else {
    Q = P.Qa + (size_t)b * SEQ * 512 + h * 64; ldq = 512; K = P.Ka + (size_t)b * SEQ * 128 + (h >> 2) * 64; ldk = 128;
    Vt = P.Vta + (size_t)(b * 2 + (h >> 2)) * 64 * SEQ; O = P.mix + (size_t)b * SEQ * 1024 + h * 64;
    slope2 = exp2f(-(float)(h + 1)) * LOG2E;
    m_run = ((GAS const float*)P.ev_sinks)[h] * LOG2E; l_run = hi ? 0.f : 1.f;
  }
  const int q0 = qb * 256, qw0 = q0 + 32 * w, qi = qw0 + r;
  bf16x8 qf[NKS];
#pragma unroll
  for (int ks = 0; ks < NKS; ++ks) qf[ks] = *(GAS const bf16x8*)(Q + (size_t)qi * ldq + 16 * ks + 8 * hi);
  f32x16 oacc[2];
#pragma unroll
  for (int i = 0; i < 16; ++i) { oacc[0][i] = 0.f; oacc[1][i] = 0.f; }
  const int kt_end = 4 * qb + 4;
  const int kt_beg = (MODE == 2) ? (qb > 0 ? 4 * qb - 2 : 0) : 0;
  const int srow = tid >> 3, sch = tid & 7;
  const unsigned soff = srow * 128 + ((sch ^ ((srow >> 1) & 7)) << 4);
  const int rrow = (tid & 255) >> 2, rch = tid & 3;
  const unsigned roff = 16384u + rrow * 64 + ((rch ^ ((rrow >> 2) & 3)) << 4);
  constexpr unsigned BUFSZ = 20736u;
  u32x4 rk, rv, rr_; f32x4 rc;
  auto gload = [&](int kt) {
    const int k0 = kt * 64;
    rk = *(GAS const u32x4*)(K + (size_t)(k0 + srow) * ldk + sch * 8);
    rv = *(GAS const u32x4*)(Vt + (size_t)srow * SEQ + k0 + sch * 8);
    if (MODE == 0) { if (tid < 256) rr_ = *(GAS const u32x4*)(Kr + (size_t)(k0 + rrow) * 32 + rch * 8); }
    if (MODE == 1) { if (tid < 16) rc = *(GAS const f32x4*)(cb + k0 + tid * 4); }
  };
  auto sstore = [&](unsigned buf) {
    *(u32x4*)(smem + buf + soff) = rk;
    *(u32x4*)(smem + buf + 8192 + soff) = rv;
    if (MODE == 0) { if (tid < 256) *(u32x4*)(smem + buf + roff) = rr_; }
    if (MODE == 1) { if (tid < 16) *(f32x4*)(smem + buf + 20480 + tid * 16) = rc; }
  };
  gload(kt_beg); sstore(0); __syncthreads();
  const int swz = (r >> 1) & 7, swr = (r >> 2) & 3;
  for (int kt = kt_beg; kt < kt_end; ++kt) {
    const unsigned cur = ((kt - kt_beg) & 1) * BUFSZ, nxt = BUFSZ - cur;
    const bool more = (kt + 1 < kt_end);
    if (more) gload(kt + 1);
    const int k0 = kt * 64;
    bool active = (k0 <= qw0 + 31);
    if (MODE == 2) active = active && (k0 + 63 > qw0 - 128);
    if (active) {
      f32x16 sacc[2];
#pragma unroll
      for (int kb = 0; kb < 2; ++kb) {
        f32x16 c0;
        if (MODE == 1) {
#pragma unroll
          for (int g = 0; g < 4; ++g) {
            const f32x4 c4 = *(const f32x4*)(smem + cur + 20480 + (32 * kb + 8 * g + 4 * hi) * 4);
            c0[4 * g] = c4[0]; c0[4 * g + 1] = c4[1]; c0[4 * g + 2] = c4[2]; c0[4 * g + 3] = c4[3];
          }
        } else {
#pragma unroll
          for (int i = 0; i < 16; ++i) c0[i] = 0.f;
        }
        sacc[kb] = c0;
#pragma unroll
        for (int ks = 0; ks < 4; ++ks) {
          bf16x8 kf = *(const bf16x8*)(smem + cur + (32 * kb + r) * 128 + (((2 * ks + hi) ^ swz) << 4));
          sacc[kb] = __builtin_amdgcn_mfma_f32_32x32x16_bf16(kf, qf[ks], sacc[kb], 0, 0, 0);
        }
        if (MODE == 0) {
#pragma unroll
          for (int ks = 0; ks < 2; ++ks) {
            bf16x8 kf = *(const bf16x8*)(smem + cur + 16384 + (32 * kb + r) * 64 + (((2 * ks + hi) ^ swr) << 4));
            sacc[kb] = __builtin_amdgcn_mfma_f32_32x32x16_bf16(kf, qf[4 + ks], sacc[kb], 0, 0, 0);
          }
        }
      }
      if (MODE == 2) {
#pragma unroll
        for (int kb = 0; kb < 2; ++kb)
#pragma unroll
          for (int i = 0; i < 16; ++i) {
            const int key = k0 + 32 * kb + 8 * (i >> 2) + 4 * hi + (i & 3);
            const int dist = qi - key;
            const float v = sacc[kb][i] - slope2 * (float)dist;
            sacc[kb][i] = (dist >= 0 && dist < 128) ? v : -INFINITY;
          }
      } else if (k0 + 63 > qw0) {
#pragma unroll
        for (int kb = 0; kb < 2; ++kb)
#pragma unroll
          for (int i = 0; i < 16; ++i) {
            const int key = k0 + 32 * kb + 8 * (i >> 2) + 4 * hi + (i & 3);
            if (key > qi) sacc[kb][i] = -INFINITY;
          }
      }
      float mx = sacc[0][0];
#pragma unroll
      for (int i = 1; i < 16; ++i) mx = fmaxf(mx, sacc[0][i]);
#pragma unroll
      for (int i = 0; i < 16; ++i) mx = fmaxf(mx, sacc[1][i]);
      mx = fmaxf(mx, __shfl_xor(mx, 32));
      if (__any(mx > m_run + 24.0f)) {
        const float m_new = fmaxf(m_run, mx);
        const float alpha = fast_exp2(m_run - m_new);
        m_run = m_new; l_run *= alpha;
        const f32x2_t a2 = {alpha, alpha};
#pragma unroll
        for (int i = 0; i < 8; ++i) {
          f32x2_t t0 = {oacc[0][2 * i], oacc[0][2 * i + 1]}, t1 = {oacc[1][2 * i], oacc[1][2 * i + 1]};
          t0 *= a2; t1 *= a2;
          oacc[0][2 * i] = t0[0]; oacc[0][2 * i + 1] = t0[1]; oacc[1][2 * i] = t1[0]; oacc[1][2 * i + 1] = t1[1];
        }
      }
      {
        const f32x2_t m2 = {m_run, m_run};
        f32x2_t ps2 = {0.f, 0.f};
#pragma unroll
        for (int kb = 0; kb < 2; ++kb)
#pragma unroll
          for (int i = 0; i < 8; ++i) {
            f32x2_t t = {sacc[kb][2 * i], sacc[kb][2 * i + 1]};
            t -= m2;
            f32x2_t e; e[0] = fast_exp2(t[0]); e[1] = fast_exp2(t[1]);
            ps2 += e;
            sacc[kb][2 * i] = e[0]; sacc[kb][2 * i + 1] = e[1];
          }
        l_run += ps2[0] + ps2[1];
      }
      bf16x8 pf[4];
#pragma unroll
      for (int a = 0; a < 4; ++a) {
        const int kb = a >> 1, o8 = (a & 1) * 8;
        u32x4 u;
        u.x = pk_bf16(sacc[kb][o8 + 0], sacc[kb][o8 + 1]); u.y = pk_bf16(sacc[kb][o8 + 2], sacc[kb][o8 + 3]);
        u.z = pk_bf16(sacc[kb][o8 + 4], sacc[kb][o8 + 5]); u.w = pk_bf16(sacc[kb][o8 + 6], sacc[kb][o8 + 7]);
        pf[a] = __builtin_bit_cast(bf16x8, u);
      }
#pragma unroll
      for (int db = 0; db < 2; ++db)
#pragma unroll
        for (int a = 0; a < 4; ++a) {
          bf16x8 vf = *(const bf16x8*)(smem + cur + 8192 + (32 * db + r) * 128 + (((2 * a + hi) ^ swz) << 4));
          oacc[db] = __builtin_amdgcn_mfma_f32_32x32x16_bf16(vf, pf[a], oacc[db], 0, 0, 0);
        }
    }
    if (more) sstore(nxt);
    __syncthreads();
  }
  const float lt = l_run + __shfl_xor(l_run, 32);
  const float inv = 1.0f / lt;
#pragma unroll
  for (int db = 0; db < 2; ++db) store_frag_bf16(O + (size_t)qi * 1024 + 32 * db, oacc[db], inv, hi);
}

__device__ __forceinline__ void phase_attn_even(const Params& P, unsigned char* smem) {
  const int bid = blockIdx.x, G = gridDim.x;
  for (int j = 0;; ++j) {
    const int u = j * G + ((j & 1) ? (G - 1 - bid) : bid);
    if (u >= 1024) break;
    const int qb = 15 - (u >> 6), pr = u & 63;
    attn_unit<0>(P, pr >> 3, pr & 7, qb, smem);
  }
  for (int u = bid; u < 1024; u += G) {
    const int qb = u >> 6, pr = u & 63;
    attn_unit<2>(P, pr >> 3, pr & 7, qb, smem);
  }
}
__device__ __forceinline__ void phase_attn_odd(const Params& P, unsigned char* smem) {
  const int bid = blockIdx.x, G = gridDim.x;
  for (int j = 0;; ++j) {
    const int u = j * G + ((j & 1) ? (G - 1 - bid) : bid);
    if (u >= 2048) break;
    const int qb = 15 - (u >> 7), pr = u & 127;
    attn_unit<1>(P, pr >> 4, pr & 15, qb, smem);
  }
}

__device__ __forceinline__ void phase_scan(const Params& P) {
  const int tid = tid_fresh(); const int lane = tid & 63, gw = blockIdx.x * (NTHREADS / 64) + (tid >> 6), nw = gridDim.x * (NTHREADS / 64);
  for (int seq = gw; seq < 128; seq += nw) {
    const int b = seq >> 4, h = seq & 15;
    GAS const float* src = (GAS const float*)(P.logf + ((size_t)b * SEQ + lane * 64) * 16 + h);
    float tot = 0.f;
#pragma unroll 16
    for (int i = 0; i < 64; ++i) tot += src[(size_t)i * 16];
    float inc = tot;
#pragma unroll
    for (int d = 1; d < 64; d <<= 1) { const float o = __shfl_up(inc, d); if (lane >= d) inc += o; }
    float run = inc - tot;
    float* dst = P.logc + (size_t)seq * SEQ + lane * 64;
#pragma unroll 4
    for (int i = 0; i < 64; i += 4) {
      f32x4 o;
      run += src[(size_t)i * 16]; o[0] = -run * LOG2E;
      run += src[(size_t)(i + 1) * 16]; o[1] = -run * LOG2E;
      run += src[(size_t)(i + 2) * 16]; o[2] = -run * LOG2E;
      run += src[(size_t)(i + 3) * 16]; o[3] = -run * LOG2E;
      *(GAS f32x4*)(dst + i) = o;
    }
  }
}

struct ConvT { int tile; bool valid; };
__device__ __forceinline__ void conv_w_pair(const float* __restrict__ src, int K, int N, bf16_t* __restrict__ dst, int dstK, const float* __restrict__ gain, int mode,
                                            ConvT ta, ConvT tb, int tiles_k, int tid0, unsigned char* smem) {
  const int tid = tid0 & 255, half = tid0 >> 8;
  const int kk = tid >> 4, rloc = (tid & 15) * 4;
  f32x4 v[2][4]; float gs[2][4];
#pragma unroll
  for (int q = 0; q < 2; ++q) {
    const ConvT t = q ? tb : ta;
    const int tk = t.tile % tiles_k, tr = t.tile / tiles_k, k0 = tk * 64, rho0 = tr * 64;
    int col = rho0 + rloc;
    if (mode == 1) { const int pn = rho0 >> 8, wi = rho0 & 255; col = (wi >> 7) * DFF + 128 * pn + (wi & 127) + rloc; }
    else if (mode == 2) { col = (col < 1152) ? col : (col < 1280 ? N : (col < 1312 ? col - 128 : N)); }
#pragma unroll
    for (int i = 0; i < 4; ++i) {
      const int k = kk + 16 * i;
      v[q][i] = (f32x4){0.f, 0.f, 0.f, 0.f}; gs[q][i] = 1.f;
      if (t.valid && col < N) v[q][i] = *(GAS const f32x4*)(src + (size_t)(k0 + k) * N + col);
      if (gain) gs[q][i] = ((GAS const float*)gain)[k0 + k];
    }
  }
#pragma unroll
  for (int q = 0; q < 2; ++q) {
    float* lds = (float*)(smem + (half * 2 + q) * 16640);
#pragma unroll
    for (int i = 0; i < 4; ++i) {
      const int k = kk + 16 * i;
      lds[k * 65 + rloc + 0] = v[q][i][0] * gs[q][i]; lds[k * 65 + rloc + 1] = v[q][i][1] * gs[q][i];
      lds[k * 65 + rloc + 2] = v[q][i][2] * gs[q][i]; lds[k * 65 + rloc + 3] = v[q][i][3] * gs[q][i];
    }
  }
  __syncthreads();
#pragma unroll
  for (int q = 0; q < 2; ++q) {
    const ConvT t = q ? tb : ta;
    if (t.valid) {
      const float* lds = (const float*)(smem + (half * 2 + q) * 16640);
      const int tk = t.tile % tiles_k, tr = t.tile / tiles_k, k0 = tk * 64, rho0 = tr * 64;
      const int rho = tid >> 2, ks = tid & 3;
      unsigned wv[8];
#pragma unroll
      for (int j = 0; j < 8; ++j) wv[j] = pk_bf16(lds[(ks * 16 + 2 * j) * 65 + rho], lds[(ks * 16 + 2 * j + 1) * 65 + rho]);
      u32x4 a = {wv[0], wv[1], wv[2], wv[3]}, b = {wv[4], wv[5], wv[6], wv[7]};
      bf16_t* o = dst + (size_t)(rho0 + rho) * dstK + k0 + ks * 16;
      *(GAS u32x4*)o = a; *(GAS u32x4*)(o + 8) = b;
    }
  }
  __syncthreads();
}

struct WJob { const float* src; bf16_t* dst; const float* gain; int K, N, NP, mode, dstK; };

__device__ __forceinline__ void phase_prologue(const Params& P, unsigned char* smem) {
  const int bid = blockIdx.x, G = gridDim.x, tid = tid_fresh(), lane = tid & 63;
  {
    const int NJ = 18;
    for (int jb = 0; jb < NJ; ++jb) {
      WJob J;
      switch (jb) {
        case 0: J = {P.ffa_gu, P.w_gu_a0, P.ffa_norm, DM, 2 * DFF, 2 * DFF, 1, DM}; break;
        case 1: J = {P.ffa_gu + (size_t)DM * 2 * DFF, P.w_gu_a1, P.ffa_norm + DM, DM, 2 * DFF, 2 * DFF, 1, DM}; break;
        case 2: J = {P.ffb_gu, P.w_gu_b0, P.ffb_norm, DM, 2 * DFF, 2 * DFF, 1, DM}; break;
        case 3: J = {P.ffb_gu + (size_t)DM * 2 * DFF, P.w_gu_b1, P.ffb_norm + DM, DM, 2 * DFF, 2 * DFF, 1, DM}; break;
        case 4: J = {P.ffa_d, P.w_d_a0, nullptr, DFF, DM, DM, 0, DFF}; break;
        case 5: J = {P.ffa_d + (size_t)DFF * DM, P.w_d_a1, nullptr, DFF, DM, DM, 0, DFF}; break;
        case 6: J = {P.ffb_d, P.w_d_b0, nullptr, DFF, DM, DM, 0, DFF}; break;
        case 7: J = {P.ffb_d + (size_t)DFF * DM, P.w_d_b1, nullptr, DFF, DM, DM, 0, DFF}; break;
        case 8: J = {P.ple_g, P.w_pg0, P.ple_norm, DM, DM, DM, 0, DM}; break;
        case 9: J = {P.ple_g + (size_t)DM * DM, P.w_pg1, P.ple_norm + DM, DM, DM, DM, 0, DM}; break;
        case 10: J = {P.ple_p, P.w_pp0, nullptr, 256, DM, DM, 0, 256}; break;
        case 11: J = {P.ple_p + (size_t)256 * DM, P.w_pp1, nullptr, 256, DM, DM, 0, 256}; break;
        case 12: J = {P.ev_in, P.w_evin, P.mix_norm, DM, 1184, N_EVIN, 2, DM}; break;
        case 13: J = {P.ev_uq, P.w_uq, P.ev_cqn, 256, 768, 768, 0, 256}; break;
        case 14: J = {P.ev_ukv, P.w_ukv, P.ev_ckvn, 128, 1024, 1024, 0, 256}; break;
        case 15: J = {P.ev_out, P.w_evout, nullptr, DM, DM, DM, 0, DM}; break;
        case 16: J = {P.od_in, P.w_odin, P.mix_norm + DM, DM, 3088, N_ODIN, 0, DM}; break;
        default: J = {P.od_out, P.w_odout, nullptr, DM, DM, DM, 0, DM}; break;
      }
      const int tiles_k = J.K >> 6, ntiles = tiles_k * (J.NP >> 6);
      for (int t0 = 2 * bid; t0 < ntiles; t0 += 4 * G) {
        const int ta = t0 + (tid >> 8), tb = ta + 2 * G;
        conv_w_pair(J.src, J.K, J.N, J.dst, J.dstK, J.gain, J.mode, ConvT{ta < ntiles ? ta : 0, ta < ntiles}, ConvT{tb < ntiles ? tb : 0, tb < ntiles}, tiles_k, tid, smem);
      }
    }
    for (int i = bid * NTHREADS + tid; i < 1024 * 16; i += G * NTHREADS) {
      const int row = i >> 4, c = i & 15;
      *(GAS u32x4*)(P.w_ukv + (size_t)row * 256 + 128 + c * 8) = (u32x4){0u, 0u, 0u, 0u};
    }
  }
  {
    const int gw = bid * (NTHREADS / 64) + (tid >> 6), nw = G * (NTHREADS / 64);
    for (int m = gw; m < NTOK; m += 2 * nw) {
      f32x4 v[2][4];
#pragma unroll
      for (int q = 0; q < 2; ++q)
#pragma unroll
        for (int i = 0; i < 4; ++i) { if (m + q * nw < NTOK) v[q][i] = *(GAS const f32x4*)(P.x + (size_t)(m + q * nw) * DM + i * 256 + lane * 4); }
#pragma unroll
      for (int q = 0; q < 2; ++q) {
        const int mm = m + q * nw;
        if (mm >= NTOK) break;
        float ss = 0.f;
#pragma unroll
        for (int i = 0; i < 4; ++i) {
          ss += (v[q][i][0] * v[q][i][0] + v[q][i][1] * v[q][i][1]) + (v[q][i][2] * v[q][i][2] + v[q][i][3] * v[q][i][3]);
          u32x2 w; w.x = pk_bf16(v[q][i][0], v[q][i][1]); w.y = pk_bf16(v[q][i][2], v[q][i][3]);
          *(GAS u32x2*)(P.hbB + (size_t)mm * DM + i * 256 + lane * 4) = w;
        }
#pragma unroll
        for (int d = 32; d >= 1; d >>= 1) ss += __shfl_xor(ss, d);
        if (lane < 16) ((GAS float*)P.ssqB)[(size_t)mm * 16 + lane] = (lane == 0) ? ss : 0.f;
      }
    }
  }
  {
    const size_t n8 = (size_t)2 * NTOK * 256 / 8, stride = (size_t)G * NTHREADS;
    for (size_t i = (size_t)bid * NTHREADS + tid; i < n8; i += 4 * stride) {
      f32x4 a[4], b[4];
#pragma unroll
      for (int q = 0; q < 4; ++q) { const size_t ii = i + q * stride; if (ii < n8) { a[q] = *(GAS const f32x4*)(P.p + ii * 8); b[q] = *(GAS const f32x4*)(P.p + ii * 8 + 4); } }
#pragma unroll
      for (int q = 0; q < 4; ++q) { const size_t ii = i + q * stride; if (ii < n8) {
        u32x4 w; w.x = pk_bf16(a[q][0], a[q][1]); w.y = pk_bf16(a[q][2], a[q][3]); w.z = pk_bf16(b[q][0], b[q][1]); w.w = pk_bf16(b[q][2], b[q][3]);
        *(GAS u32x4*)(P.pb + ii * 8) = w; } }
    }
  }
  {
    for (int i = bid * NTHREADS + tid; i < SEQ * 16; i += G * NTHREADS) {
      const int s = i >> 4, j = i & 15;
      const float inv = (float)exp2(-(double)j * (13.287712379549449 / 16.0));
      const float ang = (float)s * inv;
      double rv = (double)ang * 0.15915494309189535; rv -= floor(rv);
      const float fr = (float)rv;
      ((GAS float*)P.rope)[(size_t)s * 32 + j] = __builtin_amdgcn_cosf(fr);
      ((GAS float*)P.rope)[(size_t)s * 32 + 16 + j] = __builtin_amdgcn_sinf(fr);
    }
  }
}

__device__ __forceinline__ void phase_final(const Params& P) {
  const int tid = tid_fresh(); const int lane = tid & 63, gw = blockIdx.x * (NTHREADS / 64) + (tid >> 6), nw = gridDim.x * (NTHREADS / 64);
  for (int m = gw; m < NTOK; m += nw) {
    const f32x4 q = *(GAS const f32x4*)(P.ssqB + (size_t)m * 16 + 4 * (lane & 3));
    u32x4 hv[2];
#pragma unroll
    for (int i = 0; i < 2; ++i) hv[i] = *(GAS const u32x4*)(P.hbB + (size_t)m * DM + i * 512 + lane * 8);
    float s = (q[0] + q[1]) + (q[2] + q[3]);
    s += __shfl_xor(s, 1); s += __shfl_xor(s, 2);
    const float rs = rsqrtf(s * (1.0f / DM) + RMS_EPS);
    float* row = P.out + (size_t)m * DM;
#pragma unroll
    for (int i = 0; i < 2; ++i) {
      const f32x4 g0 = *(GAS const f32x4*)(P.final_norm + i * 512 + lane * 8), g1 = *(GAS const f32x4*)(P.final_norm + i * 512 + lane * 8 + 4);
      f32x4 o0, o1;
      o0[0] = bf_lo(hv[i].x) * rs * g0[0]; o0[1] = bf_hi(hv[i].x) * rs * g0[1]; o0[2] = bf_lo(hv[i].y) * rs * g0[2]; o0[3] = bf_hi(hv[i].y) * rs * g0[3];
      o1[0] = bf_lo(hv[i].z) * rs * g1[0]; o1[1] = bf_hi(hv[i].z) * rs * g1[1]; o1[2] = bf_lo(hv[i].w) * rs * g1[2]; o1[3] = bf_hi(hv[i].w) * rs * g1[3];
      *(GAS f32x4*)(row + i * 512 + lane * 8) = o0; *(GAS f32x4*)(row + i * 512 + lane * 8 + 4) = o1;
    }
  }
}

#define XB_TMO      128
#define XB_XCNT(j)  (256  + 64 * (j))
#define XB_XSUB(j)  (1280 + 64 * (j))
#define XB_XGEN(j)  (2304 + 64 * (j))
#define XB_TOP      3328
#define XB_TOPGEN   3392
#define XCD_BAR_WORDS 3456
#define XB_SPIN_CAP (1u << 18)

__device__ __forceinline__ unsigned xb_ld(unsigned* p)              { return __hip_atomic_load(p, __ATOMIC_RELAXED, __HIP_MEMORY_SCOPE_AGENT); }
__device__ __forceinline__ unsigned xb_add(unsigned* p, unsigned v) { return __hip_atomic_fetch_add(p, v, __ATOMIC_RELAXED, __HIP_MEMORY_SCOPE_AGENT); }
__device__ __forceinline__ unsigned xb_xcc_id() { return (unsigned)__builtin_amdgcn_s_getreg((3 << 11) | 20) & 0xFu; }
#define XB_SPIN(cond, bar) do { unsigned _sp = 0; while (cond) { __builtin_amdgcn_s_sleep(1); \
    if ((++_sp & 255u) == 0u) { if (xb_ld(&(bar)[XB_TMO])) break; if (_sp > XB_SPIN_CAP) { atomicAdd(&(bar)[XB_TMO], 1u); break; } } } } while (0)

struct XcdBarrier {
    unsigned* bar; unsigned x;
    volatile LAS unsigned* st;
};

__device__ __forceinline__ XcdBarrier xcd_barrier_post(unsigned* bar, volatile LAS unsigned* st) {
    XcdBarrier b; b.bar = bar; b.x = xb_xcc_id(); b.st = st;
    if (threadIdx.x == 0) (void)xb_add(&bar[XB_XCNT(b.x)], 1u);
    return b;
}
__device__ __forceinline__ void xcd_barrier_complete(unsigned* bar, unsigned x, unsigned& nloc, unsigned& nx) {
    const unsigned G = gridDim.x * gridDim.y * gridDim.z;
    unsigned sum, cnt, mine, sp = 0u;
    for (;;) {
        sum = 0u; cnt = 0u; mine = 0u;
#pragma unroll
        for (unsigned j = 0; j < 16; ++j) { const unsigned c = xb_ld(&bar[XB_XCNT(j)]); sum += c; cnt += (c > 0u) ? 1u : 0u; mine = (j == x) ? c : mine; }
        if (sum == G) break;
        __builtin_amdgcn_s_sleep(1);
        if ((++sp & 255u) == 0u) { if (xb_ld(&bar[XB_TMO])) break; if (sp > XB_SPIN_CAP) { atomicAdd(&bar[XB_TMO], 1u); break; } }
    }
    nloc = mine > 0u ? mine : 1u; nx = cnt > 0u ? cnt : 1u;
}

__device__ __forceinline__ void xcd_barrier(const XcdBarrier& b) {
    asm volatile("s_waitcnt vmcnt(0)" ::: "memory");
    __syncthreads();
    if (threadIdx.x == 0) {
        unsigned* bar = b.bar;
        __builtin_amdgcn_s_waitcnt(0);
        unsigned nloc = b.st[0], nx = b.st[1];
        if (nloc == 0u) { xcd_barrier_complete(bar, b.x, nloc, nx); b.st[0] = nloc; b.st[1] = nx; }
        const unsigned old = xb_add(&bar[XB_XSUB(b.x)], 1u);
        const unsigned gen = old / nloc;
        if (old + 1u == (gen + 1u) * nloc) {
            __builtin_amdgcn_fence(__ATOMIC_RELEASE, "agent");
            asm volatile("s_waitcnt vmcnt(0)" ::: "memory");
            const unsigned og = xb_add(&bar[XB_TOP], 1u);
            const unsigned tg = og / nx;
            if (og + 1u == (tg + 1u) * nx) xb_add(&bar[XB_TOPGEN], 1u);
            else XB_SPIN(xb_ld(&bar[XB_TOPGEN]) == tg, bar);
            __builtin_amdgcn_fence(__ATOMIC_ACQUIRE, "agent");
            xb_add(&bar[XB_XGEN(b.x)], 1u);
            asm volatile("s_waitcnt vmcnt(0)" ::: "memory");
        } else {
            XB_SPIN(xb_ld(&bar[XB_XGEN(b.x)]) == gen, bar);
            __builtin_amdgcn_fence(__ATOMIC_ACQUIRE, "agent");
            asm volatile("s_waitcnt vmcnt(0)" ::: "memory");
        }
    }
    __syncthreads();
}


#define PH(...) { const Params& P = kparams(); __VA_ARGS__ } xcd_barrier(xb);

template <int L>
__device__ __forceinline__ void run_layer(const XcdBarrier& xb, unsigned char* smem, LAS unsigned char* lds) {
  PH( EpiGU E{P.ssqB, P.act}; run_gemm(lds, P.hbB, L ? P.w_gu_a1 : P.w_gu_a0, 2 * DFF, DM, E); )
  PH( EpiRes<false, false> E{nullptr, P.hbB, P.hbA, P.ssqA, 0.5f, nullptr, nullptr}; run_gemm(lds, P.act, L ? P.w_d_a1 : P.w_d_a0, DM, DFF, E); )
  if (L == 0) {
    PH( EpiInEven E{0}; run_gemm(lds, P.hbA, P.w_evin, N_EVIN, DM, E); )
    PH( { EpiUQ E{P.ssq_cq, P.rope, P.Qb}; run_gemm(lds, P.cqb, P.w_uq, 768, 256, E); }
        { EpiUKV E{P.ssq_ckv, P.Kn, P.Vtb}; run_gemm(lds, P.ckvb, P.w_ukv, 1024, 256, E); } )
    PH( phase_attn_even(P, smem); )
  } else {
    PH( EpiInOdd E{0}; run_gemm(lds, P.hbA, P.w_odin, N_ODIN, DM, E); )
    PH( phase_scan(P); )
    PH( phase_attn_odd(P, smem); )
  }
  PH( EpiRes<false, false> E{nullptr, P.hbA, P.hbA, P.ssqA, 1.0f, nullptr, nullptr}; run_gemm(lds, L ? P.Qc : P.mix, L ? P.w_odout : P.w_evout, DM, DM, E); )
  PH( EpiGU E{P.ssqA, P.act}; run_gemm(lds, P.hbA, L ? P.w_gu_b1 : P.w_gu_b0, 2 * DFF, DM, E); )
  PH( EpiRes<false, false> E{nullptr, P.hbA, P.hbA, P.ssqA, 0.5f, nullptr, nullptr}; run_gemm(lds, P.act, L ? P.w_d_b1 : P.w_d_b0, DM, DFF, E); )
  PH( { EpiBf16Plain E{P.projb, DM}; run_gemm(lds, P.pb + (size_t)L * NTOK * 256, L ? P.w_pp1 : P.w_pp0, DM, 256, E); }
      { EpiRes<true, false> E{nullptr, P.hbA, P.hbB, P.ssqB, 0.f, P.ssqA, P.projb}; run_gemm(lds, P.hbA, L ? P.w_pg1 : P.w_pg0, DM, DM, E); } )
}

__global__ void __launch_bounds__(NTHREADS, 2) k_mega(Params Pdummy) {
  extern __shared__ __attribute__((aligned(16))) unsigned char lds_dyn[];
  unsigned char* smem = lds_dyn;
  LAS unsigned char* lds = (LAS unsigned char*)lds_dyn;
  cg::grid_group grid = cg::this_grid();
  if (threadIdx.x < 4) ((LAS unsigned*)(lds + 131072))[threadIdx.x] = 0u;
  __syncthreads();
  unsigned* barw; { const Params& P = kparams(); barw = P.barw; }
  const XcdBarrier xb = xcd_barrier_post(barw, (volatile LAS unsigned*)(lds + 131072));
  { const Params& P = kparams(); phase_prologue(P, smem); }
  grid.sync();
  run_layer<0>(xb, smem, lds);
  run_layer<1>(xb, smem, lds);
  { const Params& P = kparams(); phase_final(P); }
}

extern "C" void kernel_launch(void* const* d_in, const int* in_sizes, int n_in, void* d_out, int out_size, void* d_ws, size_t ws_size,
                              hipStream_t stream) {
  Params P{};
  const float** pf = (const float**)&P.x;
  for (int i = 0; i < 23; ++i) pf[i] = (const float*)d_in[i];
  P.out = (float*)d_out;
  unsigned char* ws = (unsigned char*)d_ws;
  size_t off = 0;
  auto take = [&](size_t bytes) { unsigned char* p = ws + off; off += (bytes + 255) & ~(size_t)255; return p; };
  const size_t MiB = 1024 * 1024;
  unsigned char* R1 = take(272 * MiB);
  P.act = (bf16_t*)R1;
  P.projb = (bf16_t*)R1;
  P.hbB = (bf16_t*)(R1 + 192 * MiB);
  {
    size_t o = 0;
    auto sub = [&](size_t bytes) { unsigned char* p = R1 + o; o += (bytes + 255) & ~(size_t)255; return p; };
    P.Qa = (bf16_t*)sub((size_t)NTOK * 512 * 2); P.Qb = (bf16_t*)sub((size_t)NTOK * 768 * 2);
    P.Ka = (bf16_t*)sub((size_t)NTOK * 128 * 2); P.Kn = (bf16_t*)sub((size_t)NTOK * 512 * 2); P.Kr = (bf16_t*)sub((size_t)NTOK * 32 * 2);
    P.Vta = (bf16_t*)sub((size_t)NTOK * 128 * 2); P.Vtb = (bf16_t*)sub((size_t)NTOK * 512 * 2);
    P.mix = (bf16_t*)sub((size_t)NTOK * 1024 * 2); P.cqb = (bf16_t*)sub((size_t)NTOK * 256 * 2); P.ckvb = (bf16_t*)sub((size_t)NTOK * 256 * 2);
    o = 0;
    P.Qc = (bf16_t*)sub((size_t)NTOK * 1024 * 2); P.Kc = (bf16_t*)sub((size_t)NTOK * 1024 * 2); P.Vtc = (bf16_t*)sub((size_t)NTOK * 1024 * 2);
  }
  P.hbA = (bf16_t*)take((size_t)NTOK * DM * 2);
  P.pb = (bf16_t*)take((size_t)2 * NTOK * 256 * 2);
  P.ssqA = (float*)take((size_t)NTOK * 16 * 4); P.ssqB = (float*)take((size_t)NTOK * 16 * 4);
  P.ssq_cq = (float*)take((size_t)NTOK * 4 * 4); P.ssq_ckv = (float*)take((size_t)NTOK * 4 * 4);
  P.logf = (float*)take((size_t)NTOK * 16 * 4); P.logc = (float*)take((size_t)NTOK * 16 * 4);
  P.rope = (float*)take((size_t)SEQ * 32 * 4);
  P.barw = (unsigned*)take((size_t)XCD_BAR_WORDS * 4);
  const size_t GU = (size_t)2 * DFF * DM * 2, DW = (size_t)DM * DFF * 2, SQ = (size_t)DM * DM * 2;
  P.w_gu_a0 = (bf16_t*)take(GU); P.w_gu_a1 = (bf16_t*)take(GU); P.w_gu_b0 = (bf16_t*)take(GU); P.w_gu_b1 = (bf16_t*)take(GU);
  P.w_d_a0 = (bf16_t*)take(DW); P.w_d_a1 = (bf16_t*)take(DW); P.w_d_b0 = (bf16_t*)take(DW); P.w_d_b1 = (bf16_t*)take(DW);
  P.w_pg0 = (bf16_t*)take(SQ); P.w_pg1 = (bf16_t*)take(SQ); P.w_pp0 = (bf16_t*)take((size_t)DM * 256 * 2); P.w_pp1 = (bf16_t*)take((size_t)DM * 256 * 2);
  P.w_evin = (bf16_t*)take((size_t)N_EVIN * DM * 2); P.w_uq = (bf16_t*)take((size_t)768 * 256 * 2); P.w_ukv = (bf16_t*)take((size_t)1024 * 256 * 2);
  P.w_evout = (bf16_t*)take(SQ); P.w_odin = (bf16_t*)take((size_t)N_ODIN * DM * 2); P.w_odout = (bf16_t*)take(SQ);
  if (off > ws_size) { fprintf(stderr, "workspace too small: need %zu have %zu\n", off, ws_size); return; }
  static int grid_blocks = 0;
  if (!grid_blocks) {
    int dev = 0, cus = 0, per_cu = 0;
    hipGetDevice(&dev);
    hipDeviceGetAttribute(&cus, hipDeviceAttributeMultiprocessorCount, dev);
    if (hipFuncSetAttribute((const void*)k_mega, hipFuncAttributeMaxDynamicSharedMemorySize, LDS_BYTES) != hipSuccess)
      fprintf(stderr, "hipFuncSetAttribute(MaxDynamicSharedMemorySize) failed\n");
    hipOccupancyMaxActiveBlocksPerMultiprocessor(&per_cu, k_mega, NTHREADS, LDS_BYTES);
    if (per_cu < 1) fprintf(stderr, "occupancy query says %d blocks/CU\n", per_cu);
    grid_blocks = cus & ~7;
    (void)hipGetLastError();
  }
  if (hipMemsetAsync(P.barw, 0, (size_t)XCD_BAR_WORDS * 4, stream) != hipSuccess) { fprintf(stderr, "memset of barrier words failed\n"); return; }
  void* args[] = {&P};
  hipError_t e = hipLaunchCooperativeKernel((void*)k_mega, dim3(grid_blocks), dim3(NTHREADS), args, LDS_BYTES, stream);
  if (e != hipSuccess) fprintf(stderr, "cooperative launch failed: %s (grid %d)\n", hipGetErrorString(e), grid_blocks);
}
```

```cpp
#include <hip/hip_runtime.h>
#include <hip/hip_cooperative_groups.h>
#include <stdint.h>
#include <stdio.h>
namespace cg = cooperative_groups;

__device__ __forceinline__ int tid_fresh() { int t = threadIdx.x; asm volatile("" : "+v"(t)); return t; }
namespace pg8 {
#define PG8_LAS __attribute__((address_space(3)))
typedef unsigned short bf16_t;
typedef short bf16x8 __attribute__((ext_vector_type(8)));
typedef float f32x4 __attribute__((ext_vector_type(4)));
typedef unsigned u32x4 __attribute__((ext_vector_type(4)));
constexpr int BM = 256, BK = 64, HALF = 128, HTB = HALF * BK * 2  , STAGE_BYTES = 8 * HTB, NXCD = 8, WGM = 8;

__host__ __device__ __forceinline__ int lds_byte(int r, int c) { const int st = (r >> 4) * 2 + (c >> 5), rr = r & 15, cc = c & 31, ob = rr * 64 + cc * 2; return st * 1024 + (ob ^ (((ob >> 9) & 1) << 5)); }
__host__ __device__ __forceinline__ void stage_rc(int b, int& R, int& C) { const int st = b / 1024, sb = b % 1024, swz = sb ^ (((sb >> 9) & 1) << 5); R = (st >> 1) * 16 + swz / 64; C = (st & 1) * 32 + (swz % 64) / 2; }
__host__ __device__ __forceinline__ int perm32(int rho) { const int n = rho >> 4, i = rho & 15; return 8 * (i >> 2) + 4 * n + (i & 3); }

struct Unit { int pm, pn; };
struct Gemm { const bf16_t* A; const bf16_t* Bt; int M, N, K; };

struct StaticOrder {
    int nM, nN, nwg, G, c;
    __host__ __device__ void init(int M, int N, int G_, int c_) { nM = M / BM; nN = N / BM; nwg = nM * nN; G = G_; c = c_; }
    __host__ __device__ bool next(int i, Unit& u) const {
        const long L = (long)i * G + c; if (L >= nwg) return false;
        int wgid = (int)L; { const int q = nwg / NXCD, r = nwg % NXCD, xcd = wgid % NXCD, off = wgid / NXCD; wgid = (xcd < r ? xcd * (q + 1) : r * (q + 1) + (xcd - r) * q) + off; }
        const int nig = WGM * nN, gid = wgid / nig, fm = gid * WGM, gsz = (nM - fm) < WGM ? (nM - fm) : WGM;
        u.pm = fm + ((wgid % nig) % gsz); u.pn = (wgid % nig) / gsz; return true;
    }
    __device__ __forceinline__ void a_ready(const Unit&) const {}
    __device__ __forceinline__ void done(const Unit&) const {}
};
template <class Epi, class Sched, bool ALIGN_EPI = false, bool SP2 = false>
__device__ __forceinline__ void gemm_phase(PG8_LAS unsigned char* lds, const Gemm g, const Sched& S, const Epi& E) {
    const int tid = tid_fresh(), wid = __builtin_amdgcn_readfirstlane(tid >> 6), lane = tid & 63, wr = wid >> 2, wc = wid & 3, fr = lane & 15, fq = lane >> 4;
    const int K = g.K, nt = K / BK;
    unsigned voffA[2], voffB[2];
#pragma unroll
    for (int i = 0; i < 2; ++i) { int R, C; stage_rc(tid * 16 + i * 8192, R, C); const int Rb = Epi::PERM ? ((R & ~31) + perm32(R & 31)) : R;
        voffA[i] = (unsigned)(R * K + C) * 2u; voffB[i] = (unsigned)(Rb * K + C) * 2u; }
    const size_t kstep = (size_t)(BK * 2);
    const size_t hstep = (size_t)HALF * K * 2;
    const size_t tstep = 2 * hstep;
    const unsigned ldsw = (unsigned)wid * 1024u;
    const int aoff = lds_byte(wr * 64 + fr, fq * 8), boff = lds_byte(wc * 32 + fr, fq * 8);
#define PG8_SA(b, h) (((b) * 2 + (h)) * HTB)
#define PG8_SB(b, h) ((4 + (b) * 2 + (h)) * HTB)
#define PG8_STAGE(bufoff, gbase, voff) do { _Pragma("unroll") for (int _i = 0; _i < 2; ++_i) \
        __builtin_amdgcn_global_load_lds((const unsigned*)((const char*)(gbase) + (voff)[_i]), (PG8_LAS unsigned*)(lds + (bufoff) + ldsw + _i * 8192), 16, 0, 0); } while (0)
#define PG8_LDA(dst, b, h) do { _Pragma("unroll") for (int m = 0; m < 4; ++m) _Pragma("unroll") for (int k = 0; k < 2; ++k) dst[m][k] = *(const PG8_LAS bf16x8*)(lds + PG8_SA(b, h) + aoff + m * 2048 + k * 1024); } while (0)
#define PG8_LDB(dst, b, h) do { _Pragma("unroll") for (int n = 0; n < 2; ++n) _Pragma("unroll") for (int k = 0; k < 2; ++k) dst[n][k] = *(const PG8_LAS bf16x8*)(lds + PG8_SB(b, h) + boff + n * 2048 + k * 1024); } while (0)
#define PG8_MMA(ai, bj, At, Bt) do { __builtin_amdgcn_s_setprio(1); _Pragma("unroll") for (int m = 0; m < 4; ++m) _Pragma("unroll") for (int n = 0; n < 2; ++n) _Pragma("unroll") for (int k = 0; k < 2; ++k) \
        acc[ai][bj][m][n] = __builtin_amdgcn_mfma_f32_16x16x32_bf16(Bt[n][k], At[m][k], acc[ai][bj][m][n], 0, 0, 0); __builtin_amdgcn_s_setprio(0); } while (0)
#define PG8_WAIT_V(n) asm volatile("s_waitcnt vmcnt(" #n ")" ::: "memory")
#define PG8_WAIT_L(n) asm volatile("s_waitcnt lgkmcnt(" #n ")" ::: "memory")
#define PG8_BAR __builtin_amdgcn_s_barrier()
#define PG8_SCHED __builtin_amdgcn_sched_barrier(0)
    Unit cur, nxt; int ui = 0;
    if (!S.next(0, cur)) return;
    f32x4 acc[2][2][4][2];
#pragma unroll
    for (int a = 0; a < 2; ++a)
#pragma unroll
        for (int b = 0; b < 2; ++b)
#pragma unroll
            for (int m = 0; m < 4; ++m)
#pragma unroll
                for (int n = 0; n < 2; ++n) acc[a][b][m][n] = (f32x4){0.f, 0.f, 0.f, 0.f};
    bf16x8 At[4][2], B0[2][2], B1[2][2];
    const char* cA = (const char*)g.A + (size_t)cur.pm * tstep; const char* cB = (const char*)g.Bt + (size_t)cur.pn * tstep;
    S.a_ready(cur);
    if constexpr (SP2) {
        PG8_STAGE(PG8_SB(0, 0), cB, voffB); PG8_STAGE(PG8_SB(0, 1), cB + hstep, voffB); PG8_STAGE(PG8_SA(0, 0), cA, voffA); PG8_STAGE(PG8_SA(0, 1), cA + hstep, voffA);
        if (wr == 1) PG8_BAR;
        PG8_WAIT_V(2); PG8_BAR;
        PG8_STAGE(PG8_SB(1, 0), cB + kstep, voffB); PG8_STAGE(PG8_SA(1, 0), cA + kstep, voffA); PG8_STAGE(PG8_SB(1, 1), cB + hstep + kstep, voffB);
        PG8_WAIT_V(6); PG8_BAR;
    } else {
        PG8_STAGE(PG8_SB(0, 0), cB, voffB); PG8_STAGE(PG8_SA(0, 0), cA, voffA); PG8_STAGE(PG8_SB(0, 1), cB + hstep, voffB); PG8_STAGE(PG8_SA(0, 1), cA + hstep, voffA);
        if (wr == 1) PG8_BAR;
        PG8_WAIT_V(4); PG8_BAR;
        PG8_STAGE(PG8_SB(1, 0), cB + kstep, voffB); PG8_STAGE(PG8_SA(1, 0), cA + kstep, voffA); PG8_STAGE(PG8_SB(1, 1), cB + hstep + kstep, voffB);
        PG8_WAIT_V(6); PG8_BAR;
    }
    for (;;) {
        const bool has_next = S.next(ui + 1, nxt);
        const char* nA = has_next ? (const char*)g.A + (size_t)nxt.pm * tstep : cA; const char* nB = has_next ? (const char*)g.Bt + (size_t)nxt.pn * tstep : cB;
        for (int t = 0; t < nt; t += 2) {
            const bool last = (t == nt - 2);
            const char* a1 = cA + (size_t)(t + 1) * kstep;
            const char* a2 = last ? nA : cA + (size_t)(t + 2) * kstep; const char* b2 = last ? nB : cB + (size_t)(t + 2) * kstep;
            const char* a3 = a2 + kstep; const char* b3 = b2 + kstep;
            if (last && has_next) S.a_ready(nxt);
            if constexpr (SP2) {
            PG8_LDB(B0, 0, 0); PG8_LDB(B1, 0, 1); PG8_SCHED; PG8_LDA(At, 0, 0); PG8_STAGE(PG8_SA(1, 1), a1 + hstep, voffA);
            PG8_WAIT_V(8); PG8_WAIT_L(0); PG8_BAR; PG8_MMA(0, 0, At, B0); PG8_MMA(0, 1, At, B1); PG8_BAR; PG8_SCHED;
            PG8_LDA(At, 0, 1); PG8_STAGE(PG8_SB(0, 0), b2, voffB); PG8_STAGE(PG8_SB(0, 1), b2 + hstep, voffB); PG8_STAGE(PG8_SA(0, 0), a2, voffA);
            PG8_WAIT_V(8); PG8_WAIT_L(0); PG8_BAR; PG8_MMA(1, 0, At, B0); PG8_MMA(1, 1, At, B1); PG8_BAR; PG8_SCHED;
            PG8_LDB(B0, 1, 0); PG8_LDB(B1, 1, 1); PG8_SCHED; PG8_LDA(At, 1, 0); PG8_STAGE(PG8_SA(0, 1), a2 + hstep, voffA);
            PG8_WAIT_V(8); PG8_WAIT_L(0); PG8_BAR; PG8_MMA(0, 0, At, B0); PG8_MMA(0, 1, At, B1); PG8_BAR; PG8_SCHED;
            PG8_LDA(At, 1, 1); PG8_STAGE(PG8_SB(1, 0), b3, voffB); PG8_STAGE(PG8_SB(1, 1), b3 + hstep, voffB); PG8_STAGE(PG8_SA(1, 0), a3, voffA);
            PG8_WAIT_V(8); PG8_WAIT_L(0); PG8_BAR; PG8_MMA(1, 0, At, B0); PG8_MMA(1, 1, At, B1); PG8_BAR; PG8_SCHED;
            } else {
            PG8_LDB(B0, 0, 0); PG8_SCHED; PG8_LDA(At, 0, 0); PG8_STAGE(PG8_SA(1, 1), a1 + hstep, voffA);
            PG8_WAIT_L(8); PG8_BAR; PG8_WAIT_L(0); PG8_MMA(0, 0, At, B0); PG8_BAR; PG8_SCHED;
            PG8_LDB(B1, 0, 1); PG8_STAGE(PG8_SB(0, 0), b2, voffB);
            PG8_BAR; PG8_WAIT_L(0); PG8_MMA(0, 1, At, B1); PG8_BAR;
            PG8_LDA(At, 0, 1); PG8_STAGE(PG8_SA(0, 0), a2, voffA);
            PG8_BAR; PG8_WAIT_L(0); PG8_MMA(1, 0, At, B0); PG8_BAR; PG8_SCHED;
            PG8_STAGE(PG8_SB(0, 1), b2 + hstep, voffB);
            PG8_WAIT_V(6); PG8_BAR; PG8_MMA(1, 1, At, B1); PG8_BAR;
            PG8_LDB(B0, 1, 0); PG8_SCHED; PG8_LDA(At, 1, 0); PG8_STAGE(PG8_SA(0, 1), a2 + hstep, voffA);
            PG8_WAIT_L(8); PG8_BAR; PG8_WAIT_L(0); PG8_MMA(0, 0, At, B0); PG8_BAR; PG8_SCHED;
            PG8_LDB(B1, 1, 1); PG8_STAGE(PG8_SB(1, 0), b3, voffB);
            PG8_BAR; PG8_WAIT_L(0); PG8_MMA(0, 1, At, B1); PG8_BAR;
            PG8_LDA(At, 1, 1); PG8_STAGE(PG8_SA(1, 0), a3, voffA);
            PG8_BAR; PG8_WAIT_L(0); PG8_MMA(1, 0, At, B0); PG8_BAR; PG8_SCHED;
            PG8_STAGE(PG8_SB(1, 1), b3 + hstep, voffB);
            PG8_WAIT_V(6); PG8_BAR; PG8_MMA(1, 1, At, B1); PG8_BAR;
            }
        }
        if constexpr (ALIGN_EPI) { if (wr == 0) PG8_BAR; }
        if constexpr (!Epi::AFTER_DRAIN) { E(acc, cur, wr, wc, fr, fq); S.done(cur); }
        if (!has_next) break;
#pragma unroll
        for (int a = 0; a < 2; ++a)
#pragma unroll
            for (int b = 0; b < 2; ++b)
#pragma unroll
                for (int m = 0; m < 4; ++m)
#pragma unroll
                    for (int n = 0; n < 2; ++n) acc[a][b][m][n] = (f32x4){0.f, 0.f, 0.f, 0.f};
        cur = nxt; cA = nA; cB = nB; ++ui;
        if constexpr (ALIGN_EPI) { if (wr == 1) PG8_BAR; }
    }
    PG8_WAIT_V(0);
    if constexpr (!ALIGN_EPI) { if (wr == 0) PG8_BAR; }
    PG8_BAR;
    if constexpr (Epi::AFTER_DRAIN) { E.fused(acc, cur, wr, wc, fr, fq, lds, wid, lane); S.done(cur); }
#undef PG8_SA
#undef PG8_SB
#undef PG8_STAGE
#undef PG8_LDA
#undef PG8_LDB
#undef PG8_MMA
#undef PG8_WAIT_V
#undef PG8_WAIT_L
#undef PG8_BAR
#undef PG8_SCHED
}
}

typedef unsigned short bf16_t;
typedef short bf16x8 __attribute__((ext_vector_type(8)));
typedef float f32x16 __attribute__((ext_vector_type(16)));
typedef float f32x4 __attribute__((ext_vector_type(4)));
typedef unsigned u32x4 __attribute__((ext_vector_type(4)));
typedef unsigned u32x2 __attribute__((ext_vector_type(2)));
#define LAS __attribute__((address_space(3)))
#define GAS __attribute__((address_space(1)))

#define SEQ 4096
#define NTOK 32768
#define DM 1024
#define DFF 2816
#define LOG2E 1.4426950408889634f
#define RMS_EPS 1e-6f
#define NTHREADS 512
#define LDS_BYTES (131072 + 16)
#define N_EVIN 1536
#define N_ODIN 3328

struct Params {
  const float *x, *p, *ffa_norm, *ffa_gu, *ffa_d, *mix_norm, *ffb_norm, *ffb_gu, *ffb_d, *ple_norm, *ple_g, *ple_p;
  const float *ev_in, *ev_sinks, *ev_cqn, *ev_uq, *ev_ckvn, *ev_ukv, *ev_out, *od_in, *od_bf, *od_out, *final_norm;
  float* out;
  bf16_t *hbA, *hbB, *pb, *act, *projb;
  float *ssqA, *ssqB, *ssq_cq, *ssq_ckv, *logf, *logc, *rope;
  unsigned* barw;
  bf16_t *w_gu_a0, *w_gu_a1, *w_gu_b0, *w_gu_b1, *w_d_a0, *w_d_a1, *w_d_b0, *w_d_b1;
  bf16_t *w_pg0, *w_pg1, *w_pp0, *w_pp1, *w_evin, *w_uq, *w_ukv, *w_evout, *w_odin, *w_odout;
  bf16_t *Qa, *Qb, *Ka, *Kn, *Kr, *Vta, *Vtb, *mix, *cqb, *ckvb;
  bf16_t *Qc, *Kc, *Vtc;
};

typedef __bf16 bf16x2_t __attribute__((ext_vector_type(2)));
typedef float f32x2_t __attribute__((ext_vector_type(2)));
__device__ __forceinline__ unsigned pk_bf16(float lo, float hi) {
  f32x2_t v = {lo, hi};
  bf16x2_t b = __builtin_convertvector(v, bf16x2_t);
  return __builtin_bit_cast(unsigned, b);
}
__device__ __forceinline__ bf16_t f2bf(float f) { return (bf16_t)(pk_bf16(f, 0.f) & 0xffffu); }
__device__ __forceinline__ float fast_exp2(float x) { return __builtin_amdgcn_exp2f(x); }
__device__ __forceinline__ float fast_rcp(float x) { return __builtin_amdgcn_rcpf(x); }
__device__ __forceinline__ float sigmoidf_fast(float z) { return fast_rcp(1.f + fast_exp2(-z * LOG2E)); }
__device__ __forceinline__ int perm_s(int s) { return (s & ~12) | ((s & 4) << 1) | ((s & 8) >> 1); }
__device__ __forceinline__ float bf_lo(unsigned w) { return __uint_as_float(w << 16); }
__device__ __forceinline__ float bf_hi(unsigned w) { return __uint_as_float(w & 0xffff0000u); }

__device__ __forceinline__ const Params& kparams() {
  const Params* q = (const Params*)__builtin_amdgcn_kernarg_segment_ptr();
  asm volatile("" : "+s"(q));
  return *q;
}
#define ACC_T const f32x4 (&acc)[2][2][4][2]
using pg8::Unit;
__device__ __forceinline__ int erow(const Unit& u, int ai, int wr, int m, int fr) { return u.pm * 256 + ai * 128 + wr * 64 + m * 16 + fr; }

template <int NP>
__device__ __forceinline__ void rows_rstd(const float* ssq, float invn, const Unit& u, int wr, int fr, int fq, float (&rs)[2][4]) {
#pragma unroll
  for (int ai = 0; ai < 2; ++ai)
#pragma unroll
    for (int m = 0; m < 4; ++m) {
      const int row = erow(u, ai, wr, m, fr);
      float s;
      if (NP == 16) {
        const f32x4 v = *(GAS const f32x4*)(ssq + (size_t)row * 16 + 4 * fq);
        s = (v[0] + v[1]) + (v[2] + v[3]);
        s += __shfl_xor(s, 16); s += __shfl_xor(s, 32);
      } else {
        const f32x4 v = *(GAS const f32x4*)(ssq + (size_t)row * 4);
        s = (v[0] + v[1]) + (v[2] + v[3]);
      }
      rs[ai][m] = rsqrtf(s * invn + RMS_EPS);
    }
}
template <int NP>
__device__ __forceinline__ float row_rstd(const float* ssq, float invn, int row, int fq) {
  float s;
  if (NP == 16) {
    const f32x4 v = *(GAS const f32x4*)(ssq + (size_t)row * 16 + 4 * fq);
    s = (v[0] + v[1]) + (v[2] + v[3]);
    s += __shfl_xor(s, 16); s += __shfl_xor(s, 32);
  } else {
    const f32x4 v = *(GAS const f32x4*)(ssq + (size_t)row * 4);
    s = (v[0] + v[1]) + (v[2] + v[3]);
  }
  return rsqrtf(s * invn + RMS_EPS);
}
#define ROW_FENCE() asm volatile("" ::: "memory")
__device__ __forceinline__ u32x4 pack8(const f32x4& a, const f32x4& b, float sc) {
  u32x4 w; w.x = pk_bf16(a[0] * sc, a[1] * sc); w.y = pk_bf16(a[2] * sc, a[3] * sc); w.z = pk_bf16(b[0] * sc, b[1] * sc); w.w = pk_bf16(b[2] * sc, b[3] * sc); return w;
}
__device__ __forceinline__ void store_vt8(bf16_t* base_  , const f32x4& a, const f32x4& b, float sc) {
  GAS bf16_t* base = (GAS bf16_t*)base_;
#pragma unroll
  for (int j = 0; j < 4; ++j) { base[(size_t)j * SEQ] = f2bf(a[j] * sc); base[(size_t)(4 + j) * SEQ] = f2bf(b[j] * sc); }
}
__device__ __forceinline__ u32x4 rope8(const f32x4& a, const f32x4& b, float sc, const float* tab  , int fq) {
  float v[8], p[8], o[8];
#pragma unroll
  for (int j = 0; j < 4; ++j) { v[j] = a[j] * sc; v[4 + j] = b[j] * sc; }
#pragma unroll
  for (int j = 0; j < 8; ++j) p[j] = __shfl_xor(v[j], 32);
  const f32x4 c0 = *(GAS const f32x4*)(tab + 8 * (fq & 1)), c1 = *(GAS const f32x4*)(tab + 8 * (fq & 1) + 4);
  const f32x4 s0 = *(GAS const f32x4*)(tab + 16 + 8 * (fq & 1)), s1 = *(GAS const f32x4*)(tab + 16 + 8 * (fq & 1) + 4);
#pragma unroll
  for (int j = 0; j < 8; ++j) {
    const float cc = j < 4 ? c0[j & 3] : c1[j & 3], sn = j < 4 ? s0[j & 3] : s1[j & 3];
    o[j] = (fq < 2) ? (v[j] * cc - p[j] * sn) : (p[j] * sn + v[j] * cc);
  }
  u32x4 w; w.x = pk_bf16(o[0], o[1]); w.y = pk_bf16(o[2], o[3]); w.z = pk_bf16(o[4], o[5]); w.w = pk_bf16(o[6], o[7]); return w;
}

struct EpiGU {
  static constexpr bool PERM = true, AFTER_DRAIN = false;
  const float* ssq; bf16_t* act;
  __device__ __forceinline__ void operator()(ACC_T, const Unit& u, int wr, int wc, int fr, int fq) const {
    float rs[2][4]; rows_rstd<16>(ssq, 1.0f / DM, u, wr, fr, fq, rs);
#pragma unroll
    for (int ai = 0; ai < 2; ++ai)
#pragma unroll
      for (int m = 0; m < 4; ++m) {
        const int row = erow(u, ai, wr, m, fr); const float r = rs[ai][m];
        float v[8];
#pragma unroll
        for (int n = 0; n < 2; ++n)
#pragma unroll
          for (int j = 0; j < 4; ++j) {
            const float g = acc[ai][0][m][n][j] * r, uu = acc[ai][1][m][n][j] * r;
            v[4 * n + j] = g * sigmoidf_fast(g) * uu;
          }
        u32x4 w; w.x = pk_bf16(v[0], v[1]); w.y = pk_bf16(v[2], v[3]); w.z = pk_bf16(v[4], v[5]); w.w = pk_bf16(v[6], v[7]);
        *(GAS u32x4*)(act + (size_t)row * DFF + 128 * u.pn + 32 * wc + 8 * fq) = w;
        ROW_FENCE();
      }
  }
};

struct EpiBf16Plain {
  static constexpr bool PERM = true, AFTER_DRAIN = false;
  bf16_t* o; int ld;
  __device__ __forceinline__ void operator()(ACC_T, const Unit& u, int wr, int wc, int fr, int fq) const {
#pragma unroll
    for (int ai = 0; ai < 2; ++ai)
#pragma unroll
      for (int m = 0; m < 4; ++m) {
        const int row = erow(u, ai, wr, m, fr);
#pragma unroll
        for (int bj = 0; bj < 2; ++bj)
          *(GAS u32x4*)(o + (size_t)row * ld + 256 * u.pn + 128 * bj + 32 * wc + 8 * fq) = pack8(acc[ai][bj][m][0], acc[ai][bj][m][1], 1.f);
        ROW_FENCE();
      }
  }
};

template <bool GATED, bool XIN>
struct EpiRes {
  static constexpr bool PERM = true, AFTER_DRAIN = false;
  const float* xin; const bf16_t* hres; bf16_t* hb; float* ssq_out; float scale; const float* ssq_in; const bf16_t* projb;
  __device__ __forceinline__ void operator()(ACC_T, const Unit& u, int wr, int wc, int fr, int fq) const {
    float rs[2][4];
    if (GATED) rows_rstd<16>(ssq_in, 1.0f / DM, u, wr, fr, fq, rs);
    const int cbase = 256 * u.pn + 32 * wc + 8 * fq;
    constexpr int NB = GATED ? 4 : 8;
    float ss = 0.f;
#pragma unroll
    for (int b0 = 0; b0 < 16; b0 += NB) {
      u32x4 hq[NB], pq[GATED ? NB : 1];
#pragma unroll
      for (int k = 0; k < NB; ++k) {
        const int st = b0 + k, ri = st >> 1;
        const size_t off = (size_t)erow(u, ri >> 2, wr, ri & 3, fr) * DM + cbase + 128 * (st & 1);
        hq[k] = *(GAS const u32x4*)(hres + off);
        if (GATED) pq[k] = *(GAS const u32x4*)(projb + off);
      }
#pragma unroll
      for (int k = 0; k < NB; ++k) {
        const int st = b0 + k, ri = st >> 1, bj = st & 1, ai = ri >> 2, m = ri & 3;
        const int row = erow(u, ai, wr, m, fr);
        const u32x4 hnx = hq[k];
        f32x4 h0, h1;
        h0[0] = bf_lo(hnx.x); h0[1] = bf_hi(hnx.x); h0[2] = bf_lo(hnx.y); h0[3] = bf_hi(hnx.y);
        h1[0] = bf_lo(hnx.z); h1[1] = bf_hi(hnx.z); h1[2] = bf_lo(hnx.w); h1[3] = bf_hi(hnx.w);
        const float rg = GATED ? rs[ai][m] : 0.f;
        const size_t off = (size_t)row * DM + cbase + 128 * bj;
        float pr[8];
        if (GATED) {
          const u32x4 pw = pq[k];
          pr[0] = bf_lo(pw.x); pr[1] = bf_hi(pw.x); pr[2] = bf_lo(pw.y); pr[3] = bf_hi(pw.y);
          pr[4] = bf_lo(pw.z); pr[5] = bf_hi(pw.z); pr[6] = bf_lo(pw.w); pr[7] = bf_hi(pw.w);
        }
        f32x4 v0, v1;
#pragma unroll
        for (int j = 0; j < 4; ++j) {
          const float a0 = acc[ai][bj][m][0][j], a1 = acc[ai][bj][m][1][j];
          const float d0 = GATED ? sigmoidf_fast(a0 * rg) * pr[j] : scale * a0;
          const float d1 = GATED ? sigmoidf_fast(a1 * rg) * pr[4 + j] : scale * a1;
          v0[j] = h0[j] + d0; v1[j] = h1[j] + d1;
          ss += v0[j] * v0[j] + v1[j] * v1[j];
        }
        *(GAS u32x4*)(hb + off) = pack8(v0, v1, 1.f);
        if (bj == 1) {
          ss += __shfl_xor(ss, 16); ss += __shfl_xor(ss, 32);
          if (fq == 0) ((GAS float*)ssq_out)[(size_t)row * 16 + 4 * u.pn + wc] = ss;
          ss = 0.f;
        }
      }
    }
  }
};

struct EpiInEven {
  static constexpr bool PERM = true, AFTER_DRAIN = false;
  int dummy;
  __device__ __forceinline__ void operator()(ACC_T, const Unit& u, int wr, int wc, int fr, int fq) const {
    if (u.pn == 5 && wc != 0) return;
    const Params& P = kparams();
    const float *ssq = P.ssqA, *rope = P.rope; bf16_t *Qa = P.Qa, *Ka = P.Ka, *Vta = P.Vta, *cqb = P.cqb, *ckvb = P.ckvb, *Kr = P.Kr; float *ssq_cq = P.ssq_cq, *ssq_ckv = P.ssq_ckv;
    float rs[2][4]; rows_rstd<16>(ssq, 1.0f / DM, u, wr, fr, fq, rs);
#pragma unroll
    for (int ai = 0; ai < 2; ++ai)
#pragma unroll
      for (int m = 0; m < 4; ++m) {
        const int row = erow(u, ai, wr, m, fr), b = row >> 12, s = row & (SEQ - 1); const float r = rs[ai][m];
        const int c8 = 32 * wc + 8 * fq;
        if (u.pn < 2) {
#pragma unroll
          for (int bj = 0; bj < 2; ++bj)
            *(GAS u32x4*)(Qa + (size_t)row * 512 + 256 * u.pn + 128 * bj + c8) = pack8(acc[ai][bj][m][0], acc[ai][bj][m][1], r * (0.125f * LOG2E));
        } else if (u.pn == 2) {
          *(GAS u32x4*)(Ka + (size_t)row * 128 + c8) = pack8(acc[ai][0][m][0], acc[ai][0][m][1], r);
          store_vt8(Vta + ((size_t)(b * 2 + (c8 >> 6)) * 64 + (c8 & 63)) * SEQ + perm_s(s), acc[ai][1][m][0], acc[ai][1][m][1], r);
        } else if (u.pn == 3 || u.pn == 4) {
          bf16_t* o = (u.pn == 3 ? cqb : ckvb) + (size_t)row * 256 + c8;
          float ss = 0.f;
#pragma unroll
          for (int bj = 0; bj < 2; ++bj) {
            *(GAS u32x4*)(o + 128 * bj) = pack8(acc[ai][bj][m][0], acc[ai][bj][m][1], r);
#pragma unroll
            for (int j = 0; j < 4; ++j) { const float a0 = acc[ai][bj][m][0][j] * r, a1 = acc[ai][bj][m][1][j] * r; ss += a0 * a0 + a1 * a1; }
          }
          ss += __shfl_xor(ss, 16); ss += __shfl_xor(ss, 32);
          if (fq == 0) ((GAS float*)(u.pn == 3 ? ssq_cq : ssq_ckv))[(size_t)row * 4 + wc] = ss;
        } else {
          *(GAS u32x4*)(Kr + (size_t)row * 32 + 8 * fq) = rope8(acc[ai][0][m][0], acc[ai][0][m][1], r, rope + (size_t)s * 32, fq);
        }
        ROW_FENCE();
      }
  }
};

struct EpiUQ {
  static constexpr bool PERM = true, AFTER_DRAIN = false;
  const float *ssq_cq, *rope; bf16_t* Qb;
  __device__ __forceinline__ void operator()(ACC_T, const Unit& u, int wr, int wc, int fr, int fq) const {
    const float qs = 0.10206207261596577f * LOG2E;
    float rs[2][4]; rows_rstd<4>(ssq_cq, 1.0f / 256, u, wr, fr, fq, rs);
#pragma unroll
    for (int ai = 0; ai < 2; ++ai)
#pragma unroll
      for (int m = 0; m < 4; ++m) {
        const int row = erow(u, ai, wr, m, fr), s = row & (SEQ - 1); const float r = rs[ai][m] * qs;
#pragma unroll
        for (int bj = 0; bj < 2; ++bj) {
          const int F = 8 * u.pn + 4 * bj + wc;
          bf16_t* o = Qb + (size_t)row * 768 + 32 * F + 8 * fq;
          if (F % 3 != 2) *(GAS u32x4*)o = pack8(acc[ai][bj][m][0], acc[ai][bj][m][1], r);
          else *(GAS u32x4*)o = rope8(acc[ai][bj][m][0], acc[ai][bj][m][1], r, rope + (size_t)s * 32, fq);
        }
        ROW_FENCE();
      }
  }
};

struct EpiUKV {
  static constexpr bool PERM = true, AFTER_DRAIN = false;
  const float* ssq_ckv; bf16_t *Kn, *Vtb;
  __device__ __forceinline__ void operator()(ACC_T, const Unit& u, int wr, int wc, int fr, int fq) const {
    float rs[2][4]; rows_rstd<4>(ssq_ckv, 1.0f / 128, u, wr, fr, fq, rs);
#pragma unroll
    for (int ai = 0; ai < 2; ++ai)
#pragma unroll
      for (int m = 0; m < 4; ++m) {
        const int row = erow(u, ai, wr, m, fr), b = row >> 12, s = row & (SEQ - 1); const float r = rs[ai][m];
#pragma unroll
        for (int bj = 0; bj < 2; ++bj) {
          const int head = 2 * u.pn + bj, within = 32 * wc + 8 * fq;
          if (wc < 2) *(GAS u32x4*)(Kn + (size_t)row * 512 + head * 64 + within) = pack8(acc[ai][bj][m][0], acc[ai][bj][m][1], r);
          else store_vt8(Vtb + ((size_t)(b * 8 + head) * 64 + (within - 64)) * SEQ + perm_s(s), acc[ai][bj][m][0], acc[ai][bj][m][1], r);
        }
        ROW_FENCE();
      }
  }
};

struct EpiInOdd {
  static constexpr bool PERM = true, AFTER_DRAIN = false;
  int dummy;
  __device__ __forceinline__ void operator()(ACC_T, const Unit& u, int wr, int wc, int fr, int fq) const {
    if (u.pn == 12 && wc != 0) return;
    const Params& P = kparams();
    const float *ssq = P.ssqA, *bfp = P.od_bf; bf16_t *Qc = P.Qc, *Kc = P.Kc, *Vtc = P.Vtc; float* logf = P.logf;
    float rs[2][4]; rows_rstd<16>(ssq, 1.0f / DM, u, wr, fr, fq, rs);
#pragma unroll
    for (int ai = 0; ai < 2; ++ai)
#pragma unroll
      for (int m = 0; m < 4; ++m) {
        const int row = erow(u, ai, wr, m, fr), b = row >> 12, s = row & (SEQ - 1); const float r = rs[ai][m];
        if (u.pn < 8) {
          bf16_t* o = (u.pn < 4 ? Qc : Kc) + (size_t)row * 1024 + 256 * (u.pn & 3) + 32 * wc + 8 * fq;
          const float sc = u.pn < 4 ? r * (0.125f * LOG2E) : r;
#pragma unroll
          for (int bj = 0; bj < 2; ++bj) *(GAS u32x4*)(o + 128 * bj) = pack8(acc[ai][bj][m][0], acc[ai][bj][m][1], sc);
        } else if (u.pn < 12) {
#pragma unroll
          for (int bj = 0; bj < 2; ++bj) {
            const int c = 256 * (u.pn - 8) + 128 * bj + 32 * wc + 8 * fq;
            store_vt8(Vtc + ((size_t)(b * 16 + (c >> 6)) * 64 + (c & 63)) * SEQ + perm_s(s), acc[ai][bj][m][0], acc[ai][bj][m][1], r);
          }
        } else if (fq < 2) {
          f32x4 o0, o1;
          const f32x4 b0 = *(GAS const f32x4*)(bfp + 8 * fq), b1 = *(GAS const f32x4*)(bfp + 8 * fq + 4);
#pragma unroll
          for (int j = 0; j < 4; ++j) {
            const float x0 = acc[ai][0][m][0][j] * r + b0[j], x1 = acc[ai][0][m][1][j] * r + b1[j];
            o0[j] = fminf(x0, 0.f) - log1pf(__expf(-fabsf(x0)));
            o1[j] = fminf(x1, 0.f) - log1pf(__expf(-fabsf(x1)));
          }
          *(GAS f32x4*)(logf + (size_t)row * 16 + 8 * fq) = o0; *(GAS f32x4*)(logf + (size_t)row * 16 + 8 * fq + 4) = o1;
        }
        ROW_FENCE();
      }
  }
};

template <bool ALIGN = true, class Epi>
__device__ __forceinline__ void run_gemm(LAS unsigned char* lds, const bf16_t* A, const bf16_t* Bt, int N, int K, const Epi& E) {
  asm volatile("" : "+s"(N), "+s"(K));
  pg8::Gemm g{A, Bt, NTOK, N, K};
  pg8::StaticOrder S; S.init(NTOK, N, (int)gridDim.x, (int)blockIdx.x);
  pg8::gemm_phase<Epi, pg8::StaticOrder, ALIGN, true>(lds, g, S, E);
}

__device__ __forceinline__ void store_frag_bf16(bf16_t* base, const f32x16& a, float sc, int hi) {
#pragma unroll
  for (int g = 0; g < 4; ++g) {
    u32x2 w; w.x = pk_bf16(a[4 * g] * sc, a[4 * g + 1] * sc); w.y = pk_bf16(a[4 * g + 2] * sc, a[4 * g + 3] * sc);
    *(GAS u32x2*)(base + 8 * g + 4 * hi) = w;
  }
}
template <int MODE>
__device__ __forceinline__ void attn_unit(const Params& P, int b, int h, int qb, unsigned char* smem) {
  const int tid = tid_fresh(), lane = tid & 63, w = tid >> 6, r = lane & 31, hi = lane >> 5;
  constexpr int NKS = (MODE == 0) ? 6 : 4;
  const bf16_t *Q, *K, *Kr = nullptr, *Vt; bf16_t* O; int ldq, ldk; const float* cb = nullptr;
  float slope2 = 0.f, m_run = -1e30f, l_run = 0.f;
  if (MODE == 0) {
    Q = P.Qb + (size_t)b * SEQ * 768 + h * 96; ldq = 768; K = P.Kn + (size_t)b * SEQ * 512 + h * 64; ldk = 512;
    Kr = P.Kr + (size_t)b * SEQ * 32; Vt = P.Vtb + (size_t)(b * 8 + h) * 64 * SEQ; O = P.mix + (size_t)b * SEQ * 1024 + 512 + h * 64;
  } else if (MODE == 1) {
    Q = P.Qc + (size_t)b * SEQ * 1024 + h * 64; ldq = 1024; K = P.Kc + (size_t)b * SEQ * 1024 + h * 64; ldk = 1024;
    Vt = P.Vtc + (size_t)(b * 16 + h) * 64 * SEQ; O = P.Qc + (size_t)b * SEQ * 1024 + h * 64; cb = P.logc + (size_t)(b * 16 + h) * SEQ;
  } else {
    Q = P.Qa + (size_t)b * SEQ * 512 + h * 64; ldq = 512; K = P.Ka + (size_t)b * SEQ * 128 + (h >> 2) * 64; ldk = 128;
    Vt = P.Vta + (size_t)(b * 2 + (h >> 2)) * 64 * SEQ; O = P.mix + (size_t)b * SEQ * 1024 + h * 64;
    slope2 = exp2f(-(float)(h + 1)) * LOG2E;
    m_run = ((GAS const float*)P.ev_sinks)[h] * LOG2E; l_run = hi ? 0.f : 1.f;
  }
  const int q0 = qb * 256, qw0 = q0 + 32 * w, qi = qw0 + r;
  bf16x8 qf[NKS];
#pragma unroll
  for (int ks = 0; ks < NKS; ++ks) qf[ks] = *(GAS const bf16x8*)(Q + (size_t)qi * ldq + 16 * ks + 8 * hi);
  f32x16 oacc[2];
#pragma unroll
  for (int i = 0; i < 16; ++i) { oacc[0][i] = 0.f; oacc[1][i] = 0.f; }
  const int kt_end = 4 * qb + 4;
  const int kt_beg = (MODE == 2) ? (qb > 0 ? 4 * qb - 2 : 0) : 0;
  const int srow = tid >> 3, sch = tid & 7;
  const unsigned soff = srow * 128 + ((sch ^ ((srow >> 1) & 7)) << 4);
  const int rrow = (tid & 255) >> 2, rch = tid & 3;
  const unsigned roff = 16384u + rrow * 64 + ((rch ^ ((rrow >> 2) & 3)) << 4);
  constexpr unsigned BUFSZ = 20736u;
  u32x4 rk, rv, rr_; f32x4 rc;
  auto gload = [&](int kt) {
    const int k0 = kt * 64;
    rk = *(GAS const u32x4*)(K + (size_t)(k0 + srow) * ldk + sch * 8);
    rv = *(GAS const u32x4*)(Vt + (size_t)srow * SEQ + k0 + sch * 8);
    if (MODE == 0) { if (tid < 256) rr_ = *(GAS const u32x4*)(Kr + (size_t)(k0 + rrow) * 32 + rch * 8); }
    if (MODE == 1) { if (tid < 16) rc = *(GAS const f32x4*)(cb + k0 + tid * 4); }
  };
  auto sstore = [&](unsigned buf) {
    *(u32x4*)(smem + buf + soff) = rk;
    *(u32x4*)(smem + buf + 8192 + soff) = rv;
    if (MODE == 0) { if (tid < 256) *(u32x4*)(smem + buf + roff) = rr_; }
    if (MODE == 1) { if (tid < 16) *(f32x4*)(smem + buf + 20480 + tid * 16) = rc; }
  };
  gload(kt_beg); sstore(0); __syncthreads();
  const int swz = (r >> 1) & 7, swr = (r >> 2) & 3;
  for (int kt = kt_beg; kt < kt_end; ++kt) {
    const unsigned cur = ((kt - kt_beg) & 1) * BUFSZ, nxt = BUFSZ - cur;
    const bool more = (kt + 1 < kt_end);
    if (more) gload(kt + 1);
    const int k0 = kt * 64;
    bool active = (k0 <= qw0 + 31);
    if (MODE == 2) active = active && (k0 + 63 > qw0 - 128);
    if (active) {
      f32x16 sacc[2];
#pragma unroll
      for (int kb = 0; kb < 2; ++kb) {
        f32x16 c0;
        if (MODE == 1) {
#pragma unroll
          for (int g = 0; g < 4; ++g) {
            const f32x4 c4 = *(const f32x4*)(smem + cur + 20480 + (32 * kb + 8 * g + 4 * hi) * 4);
            c0[4 * g] = c4[0]; c0[4 * g + 1] = c4[1]; c0[4 * g + 2] = c4[2]; c0[4 * g + 3] = c4[3];
          }
        } else {
#pragma unroll
          for (int i = 0; i < 16; ++i) c0[i] = 0.f;
        }
        sacc[kb] = c0;
#pragma unroll
        for (int ks = 0; ks < 4; ++ks) {
          bf16x8 kf = *(const bf16x8*)(smem + cur + (32 * kb + r) * 128 + (((2 * ks + hi) ^ swz) << 4));
          sacc[kb] = __builtin_amdgcn_mfma_f32_32x32x16_bf16(kf, qf[ks], sacc[kb], 0, 0, 0);
        }
        if (MODE == 0) {
#pragma unroll
          for (int ks = 0; ks < 2; ++ks) {
            bf16x8 kf = *(const bf16x8*)(smem + cur + 16384 + (32 * kb + r) * 64 + (((2 * ks + hi) ^ swr) << 4));
            sacc[kb] = __builtin_amdgcn_mfma_f32_32x32x16_bf16(kf, qf[4 + ks], sacc[kb], 0, 0, 0);
          }
        }
      }
      if (MODE == 2) {
#pragma unroll
        for (int kb = 0; kb < 2; ++kb)
#pragma unroll
          for (int i = 0; i < 16; ++i) {
            const int key = k0 + 32 * kb + 8 * (i >> 2) + 4 * hi + (i & 3);
            const int dist = qi - key;
            const float v = sacc[kb][i] - slope2 * (float)dist;
            sacc[kb][i] = (dist >= 0 && dist < 128) ? v : -INFINITY;
          }
      } else if (k0 + 63 > qw0) {
#pragma unroll
        for (int kb = 0; kb < 2; ++kb)
#pragma unroll
          for (int i = 0; i < 16; ++i) {
            const int key = k0 + 32 * kb + 8 * (i >> 2) + 4 * hi + (i & 3);
            if (key > qi) sacc[kb][i] = -INFINITY;
          }
      }
      float mx = sacc[0][0];
#pragma unroll
      for (int i = 1; i < 16; ++i) mx = fmaxf(mx, sacc[0][i]);
#pragma unroll
      for (int i = 0; i < 16; ++i) mx = fmaxf(mx, sacc[1][i]);
      mx = fmaxf(mx, __shfl_xor(mx, 32));
      if (__any(mx > m_run + 24.0f)) {
        const float m_new = fmaxf(m_run, mx);
        const float alpha = fast_exp2(m_run - m_new);
        m_run = m_new; l_run *= alpha;
        const f32x2_t a2 = {alpha, alpha};
#pragma unroll
        for (int i = 0; i < 8; ++i) {
          f32x2_t t0 = {oacc[0][2 * i], oacc[0][2 * i + 1]}, t1 = {oacc[1][2 * i], oacc[1][2 * i + 1]};
          t0 *= a2; t1 *= a2;
          oacc[0][2 * i] = t0[0]; oacc[0][2 * i + 1] = t0[1]; oacc[1][2 * i] = t1[0]; oacc[1][2 * i + 1] = t1[1];
        }
      }
      {
        const f32x2_t m2 = {m_run, m_run};
        f32x2_t ps2 = {0.f, 0.f};
#pragma unroll
        for (int kb = 0; kb < 2; ++kb)
#pragma unroll
          for (int i = 0; i < 8; ++i) {
            f32x2_t t = {sacc[kb][2 * i], sacc[kb][2 * i + 1]};
            t -= m2;
            f32x2_t e; e[0] = fast_exp2(t[0]); e[1] = fast_exp2(t[1]);
            ps2 += e;
            sacc[kb][2 * i] = e[0]; sacc[kb][2 * i + 1] = e[1];
          }
        l_run += ps2[0] + ps2[1];
      }
      bf16x8 pf[4];
#pragma unroll
      for (int a = 0; a < 4; ++a) {
        const int kb = a >> 1, o8 = (a & 1) * 8;
        u32x4 u;
        u.x = pk_bf16(sacc[kb][o8 + 0], sacc[kb][o8 + 1]); u.y = pk_bf16(sacc[kb][o8 + 2], sacc[kb][o8 + 3]);
        u.z = pk_bf16(sacc[kb][o8 + 4], sacc[kb][o8 + 5]); u.w = pk_bf16(sacc[kb][o8 + 6], sacc[kb][o8 + 7]);
        pf[a] = __builtin_bit_cast(bf16x8, u);
      }
#pragma unroll
      for (int db = 0; db < 2; ++db)
#pragma unroll
        for (int a = 0; a < 4; ++a) {
          bf16x8 vf = *(const bf16x8*)(smem + cur + 8192 + (32 * db + r) * 128 + (((2 * a + hi) ^ swz) << 4));
          oacc[db] = __builtin_amdgcn_mfma_f32_32x32x16_bf16(vf, pf[a], oacc[db], 0, 0, 0);
        }
    }
    if (more) sstore(nxt);
    __syncthreads();
  }
  const float lt = l_run + __shfl_xor(l_run, 32);
  const float inv = 1.0f / lt;
#pragma unroll
  for (int db = 0; db < 2; ++db) store_frag_bf16(O + (size_t)qi * 1024 + 32 * db, oacc[db], inv, hi);
}

__device__ __forceinline__ void phase_attn_even(const Params& P, unsigned char* smem) {
  const int bid = blockIdx.x, G = gridDim.x;
  for (int j = 0;; ++j) {
    const int u = j * G + ((j & 1) ? (G - 1 - bid) : bid);
    if (u >= 1024) break;
    const int qb = 15 - (u >> 6), pr = u & 63;
    attn_unit<0>(P, pr >> 3, pr & 7, qb, smem);
  }
  for (int u = bid; u < 1024; u += G) {
    const int qb = u >> 6, pr = u & 63;
    attn_unit<2>(P, pr >> 3, pr & 7, qb, smem);
  }
}
__device__ __forceinline__ void phase_attn_odd(const Params& P, unsigned char* smem) {
  const int bid = blockIdx.x, G = gridDim.x;
  for (int j = 0;; ++j) {
    const int u = j * G + ((j & 1) ? (G - 1 - bid) : bid);
    if (u >= 2048) break;
    const int qb = 15 - (u >> 7), pr = u & 127;
    attn_unit<1>(P, pr >> 4, pr & 15, qb, smem);
  }
}

__device__ __forceinline__ void phase_scan(const Params& P) {
  const int tid = tid_fresh(); const int lane = tid & 63, gw = blockIdx.x * (NTHREADS / 64) + (tid >> 6), nw = gridDim.x * (NTHREADS / 64);
  for (int seq = gw; seq < 128; seq += nw) {
    const int b = seq >> 4, h = seq & 15;
    GAS const float* src = (GAS const float*)(P.logf + ((size_t)b * SEQ + lane * 64) * 16 + h);
    float tot = 0.f;
#pragma unroll 16
    for (int i = 0; i < 64; ++i) tot += src[(size_t)i * 16];
    float inc = tot;
#pragma unroll
    for (int d = 1; d < 64; d <<= 1) { const float o = __shfl_up(inc, d); if (lane >= d) inc += o; }
    float run = inc - tot;
    float* dst = P.logc + (size_t)seq * SEQ + lane * 64;
#pragma unroll 4
    for (int i = 0; i < 64; i += 4) {
      f32x4 o;
      run += src[(size_t)i * 16]; o[0] = -run * LOG2E;
      run += src[(size_t)(i + 1) * 16]; o[1] = -run * LOG2E;
      run += src[(size_t)(i + 2) * 16]; o[2] = -run * LOG2E;
      run += src[(size_t)(i + 3) * 16]; o[3] = -run * LOG2E;
      *(GAS f32x4*)(dst + i) = o;
    }
  }
}

struct WJob { const float* src; bf16_t* dst; const float* gain; int K, N, NP, mode, dstK; };
struct ConvT { WJob J; int tile; bool valid; };
__device__ __forceinline__ WJob conv_job(const Params& P, int jb) {
  WJob J;
  switch (jb) {
    case 0: J = {P.ffa_gu, P.w_gu_a0, P.ffa_norm, DM, 2 * DFF, 2 * DFF, 1, DM}; break;
    case 1: J = {P.ffa_gu + (size_t)DM * 2 * DFF, P.w_gu_a1, P.ffa_norm + DM, DM, 2 * DFF, 2 * DFF, 1, DM}; break;
    case 2: J = {P.ffb_gu, P.w_gu_b0, P.ffb_norm, DM, 2 * DFF, 2 * DFF, 1, DM}; break;
    case 3: J = {P.ffb_gu + (size_t)DM * 2 * DFF, P.w_gu_b1, P.ffb_norm + DM, DM, 2 * DFF, 2 * DFF, 1, DM}; break;
    case 4: J = {P.ffa_d, P.w_d_a0, nullptr, DFF, DM, DM, 0, DFF}; break;
    case 5: J = {P.ffa_d + (size_t)DFF * DM, P.w_d_a1, nullptr, DFF, DM, DM, 0, DFF}; break;
    case 6: J = {P.ffb_d, P.w_d_b0, nullptr, DFF, DM, DM, 0, DFF}; break;
    case 7: J = {P.ffb_d + (size_t)DFF * DM, P.w_d_b1, nullptr, DFF, DM, DM, 0, DFF}; break;
    case 8: J = {P.ple_g, P.w_pg0, P.ple_norm, DM, DM, DM, 0, DM}; break;
    case 9: J = {P.ple_g + (size_t)DM * DM, P.w_pg1, P.ple_norm + DM, DM, DM, DM, 0, DM}; break;
    case 10: J = {P.ple_p, P.w_pp0, nullptr, 256, DM, DM, 0, 256}; break;
    case 11: J = {P.ple_p + (size_t)256 * DM, P.w_pp1, nullptr, 256, DM, DM, 0, 256}; break;
    case 12: J = {P.ev_in, P.w_evin, P.mix_norm, DM, 1184, N_EVIN, 2, DM}; break;
    case 13: J = {P.ev_uq, P.w_uq, P.ev_cqn, 256, 768, 768, 0, 256}; break;
    case 14: J = {P.ev_ukv, P.w_ukv, P.ev_ckvn, 128, 1024, 1024, 0, 256}; break;
    case 15: J = {P.ev_out, P.w_evout, nullptr, DM, DM, DM, 0, DM}; break;
    case 16: J = {P.od_in, P.w_odin, P.mix_norm + DM, DM, 3088, N_ODIN, 0, DM}; break;
    default: J = {P.od_out, P.w_odout, nullptr, DM, DM, DM, 0, DM}; break;
  }
  return J;
}
__device__ __forceinline__ int conv_job_tiles(int jb) {
  return jb < 4 ? 1408 : jb < 8 ? 704 : jb < 10 ? 256 : jb < 12 ? 64 : jb == 12 ? 384 : jb == 13 ? 48 : jb == 14 ? 32 : jb == 15 ? 256 : jb == 16 ? 832 : 256;
}
constexpr int CONV_TILES = 4 * 1408 + 4 * 704 + 2 * 256 + 2 * 64 + 384 + 48 + 32 + 256 + 832 + 256;
__device__ __forceinline__ ConvT conv_locate(const Params& P, int g) {
  ConvT t; t.valid = g < CONV_TILES; t.tile = 0;
  int jb = 0, base = 0;
  if (t.valid) {
#pragma unroll 1
    for (; jb < 17; ++jb) { const int n = conv_job_tiles(jb); if (g < base + n) break; base += n; }
    t.tile = g - base;
  }
  t.J = conv_job(P, jb);
  return t;
}
__device__ __forceinline__ void conv_w_pair(const ConvT& ta, const ConvT& tb, int tid0, unsigned char* smem) {
  const int tid = tid0 & 255, half = tid0 >> 8;
  const int kk = tid >> 4, rloc = (tid & 15) * 4;
  f32x4 v[2][4]; float gs[2][4];
#pragma unroll
  for (int q = 0; q < 2; ++q) {
    const ConvT& t = q ? tb : ta;
    const int tiles_k = t.J.K >> 6, N = t.J.N;
    const int tk = t.tile % tiles_k, tr = t.tile / tiles_k, k0 = tk * 64, rho0 = tr * 64;
    int col = rho0 + rloc;
    if (t.J.mode == 1) { const int pn = rho0 >> 8, wi = rho0 & 255; col = (wi >> 7) * DFF + 128 * pn + (wi & 127) + rloc; }
    else if (t.J.mode == 2) { col = (col < 1152) ? col : (col < 1280 ? N : (col < 1312 ? col - 128 : N)); }
#pragma unroll
    for (int i = 0; i < 4; ++i) {
      const int k = kk + 16 * i;
      v[q][i] = (f32x4){0.f, 0.f, 0.f, 0.f}; gs[q][i] = 1.f;
      if (t.valid && col < N) v[q][i] = *(GAS const f32x4*)(t.J.src + (size_t)(k0 + k) * N + col);
      if (t.J.gain) gs[q][i] = ((GAS const float*)t.J.gain)[k0 + k];
    }
  }
#pragma unroll
  for (int q = 0; q < 2; ++q) {
    float* lds = (float*)(smem + (half * 2 + q) * 16640);
#pragma unroll
    for (int i = 0; i < 4; ++i) {
      const int k = kk + 16 * i;
      lds[k * 65 + rloc + 0] = v[q][i][0] * gs[q][i]; lds[k * 65 + rloc + 1] = v[q][i][1] * gs[q][i];
      lds[k * 65 + rloc + 2] = v[q][i][2] * gs[q][i]; lds[k * 65 + rloc + 3] = v[q][i][3] * gs[q][i];
    }
  }
  __syncthreads();
#pragma unroll
  for (int q = 0; q < 2; ++q) {
    const ConvT& t = q ? tb : ta;
    if (t.valid) {
      const float* lds = (const float*)(smem + (half * 2 + q) * 16640);
      const int tiles_k = t.J.K >> 6;
      const int tk = t.tile % tiles_k, tr = t.tile / tiles_k, k0 = tk * 64, rho0 = tr * 64;
      const int rho = tid >> 2, ks = tid & 3;
      unsigned wv[8];
#pragma unroll
      for (int j = 0; j < 8; ++j) wv[j] = pk_bf16(lds[(ks * 16 + 2 * j) * 65 + rho], lds[(ks * 16 + 2 * j + 1) * 65 + rho]);
      u32x4 a = {wv[0], wv[1], wv[2], wv[3]}, b = {wv[4], wv[5], wv[6], wv[7]};
      bf16_t* o = t.J.dst + (size_t)(rho0 + rho) * t.J.dstK + k0 + ks * 16;
      *(GAS u32x4*)o = a; *(GAS u32x4*)(o + 8) = b;
    }
  }
  __syncthreads();
}

__device__ __forceinline__ void phase_prologue(const Params& P, unsigned char* smem) {
  const int bid = blockIdx.x, G = gridDim.x, tid = tid_fresh(), lane = tid & 63;
  {
    for (int g0 = 2 * bid; g0 < CONV_TILES; g0 += 4 * G) {
      const int ga = g0 + (tid >> 8), gb = ga + 2 * G;
      const ConvT ta = conv_locate(P, ga), tb = conv_locate(P, gb);
      conv_w_pair(ta, tb, tid, smem);
    }
    for (int i = bid * NTHREADS + tid; i < 1024 * 16; i += G * NTHREADS) {
      const int row = i >> 4, c = i & 15;
      *(GAS u32x4*)(P.w_ukv + (size_t)row * 256 + 128 + c * 8) = (u32x4){0u, 0u, 0u, 0u};
    }
  }
  {
    const int gw = bid * (NTHREADS / 64) + (tid >> 6), nw = G * (NTHREADS / 64);
    for (int m = gw; m < NTOK; m += 2 * nw) {
      f32x4 v[2][4];
#pragma unroll
      for (int q = 0; q < 2; ++q)
#pragma unroll
        for (int i = 0; i < 4; ++i) { if (m + q * nw < NTOK) v[q][i] = *(GAS const f32x4*)(P.x + (size_t)(m + q * nw) * DM + i * 256 + lane * 4); }
#pragma unroll
      for (int q = 0; q < 2; ++q) {
        const int mm = m + q * nw;
        if (mm >= NTOK) break;
        float ss = 0.f;
#pragma unroll
        for (int i = 0; i < 4; ++i) {
          ss += (v[q][i][0] * v[q][i][0] + v[q][i][1] * v[q][i][1]) + (v[q][i][2] * v[q][i][2] + v[q][i][3] * v[q][i][3]);
          u32x2 w; w.x = pk_bf16(v[q][i][0], v[q][i][1]); w.y = pk_bf16(v[q][i][2], v[q][i][3]);
          *(GAS u32x2*)(P.hbB + (size_t)mm * DM + i * 256 + lane * 4) = w;
        }
#pragma unroll
        for (int d = 32; d >= 1; d >>= 1) ss += __shfl_xor(ss, d);
        if (lane < 16) ((GAS float*)P.ssqB)[(size_t)mm * 16 + lane] = (lane == 0) ? ss : 0.f;
      }
    }
  }
  {
    const size_t n8 = (size_t)2 * NTOK * 256 / 8, stride = (size_t)G * NTHREADS;
    for (size_t i = (size_t)bid * NTHREADS + tid; i < n8; i += 4 * stride) {
      f32x4 a[4], b[4];
#pragma unroll
      for (int q = 0; q < 4; ++q) { const size_t ii = i + q * stride; if (ii < n8) { a[q] = *(GAS const f32x4*)(P.p + ii * 8); b[q] = *(GAS const f32x4*)(P.p + ii * 8 + 4); } }
#pragma unroll
      for (int q = 0; q < 4; ++q) { const size_t ii = i + q * stride; if (ii < n8) {
        u32x4 w; w.x = pk_bf16(a[q][0], a[q][1]); w.y = pk_bf16(a[q][2], a[q][3]); w.z = pk_bf16(b[q][0], b[q][1]); w.w = pk_bf16(b[q][2], b[q][3]);
        *(GAS u32x4*)(P.pb + ii * 8) = w; } }
    }
  }
  {
    for (int i = bid * NTHREADS + tid; i < SEQ * 16; i += G * NTHREADS) {
      const int s = i >> 4, j = i & 15;
      const float inv = (float)exp2(-(double)j * (13.287712379549449 / 16.0));
      const float ang = (float)s * inv;
      double rv = (double)ang * 0.15915494309189535; rv -= floor(rv);
      const float fr = (float)rv;
      ((GAS float*)P.rope)[(size_t)s * 32 + j] = __builtin_amdgcn_cosf(fr);
      ((GAS float*)P.rope)[(size_t)s * 32 + 16 + j] = __builtin_amdgcn_sinf(fr);
    }
  }
}

__device__ __forceinline__ void phase_final(const Params& P) {
  const int tid = tid_fresh(); const int lane = tid & 63, gw = blockIdx.x * (NTHREADS / 64) + (tid >> 6), nw = gridDim.x * (NTHREADS / 64);
  for (int m = gw; m < NTOK; m += nw) {
    const f32x4 q = *(GAS const f32x4*)(P.ssqB + (size_t)m * 16 + 4 * (lane & 3));
    u32x4 hv[2];
#pragma unroll
    for (int i = 0; i < 2; ++i) hv[i] = *(GAS const u32x4*)(P.hbB + (size_t)m * DM + i * 512 + lane * 8);
    float s = (q[0] + q[1]) + (q[2] + q[3]);
    s += __shfl_xor(s, 1); s += __shfl_xor(s, 2);
    const float rs = rsqrtf(s * (1.0f / DM) + RMS_EPS);
    float* row = P.out + (size_t)m * DM;
#pragma unroll
    for (int i = 0; i < 2; ++i) {
      const f32x4 g0 = *(GAS const f32x4*)(P.final_norm + i * 512 + lane * 8), g1 = *(GAS const f32x4*)(P.final_norm + i * 512 + lane * 8 + 4);
      f32x4 o0, o1;
      o0[0] = bf_lo(hv[i].x) * rs * g0[0]; o0[1] = bf_hi(hv[i].x) * rs * g0[1]; o0[2] = bf_lo(hv[i].y) * rs * g0[2]; o0[3] = bf_hi(hv[i].y) * rs * g0[3];
      o1[0] = bf_lo(hv[i].z) * rs * g1[0]; o1[1] = bf_hi(hv[i].z) * rs * g1[1]; o1[2] = bf_lo(hv[i].w) * rs * g1[2]; o1[3] = bf_hi(hv[i].w) * rs * g1[3];
      *(GAS f32x4*)(row + i * 512 + lane * 8) = o0; *(GAS f32x4*)(row + i * 512 + lane * 8 + 4) = o1;
    }
  }
}

#define XB_TMO      128
#define XB_XCNT(j)  (256  + 64 * (j))
#define XB_XSUB(j)  (1280 + 64 * (j))
#define XB_XGEN(j)  (2304 + 64 * (j))
#define XB_TOP      3328
#define XB_TOPGEN   3392
#define XCD_BAR_WORDS 3456
#define XB_SPIN_CAP (1u << 18)

__device__ __forceinline__ unsigned xb_ld(unsigned* p)              { return __hip_atomic_load(p, __ATOMIC_RELAXED, __HIP_MEMORY_SCOPE_AGENT); }
__device__ __forceinline__ unsigned xb_add(unsigned* p, unsigned v) { return __hip_atomic_fetch_add(p, v, __ATOMIC_RELAXED, __HIP_MEMORY_SCOPE_AGENT); }
__device__ __forceinline__ unsigned xb_xcc_id() { return (unsigned)__builtin_amdgcn_s_getreg((3 << 11) | 20) & 0xFu; }
#define XB_SPIN(cond, bar) do { unsigned _sp = 0; while (cond) { __builtin_amdgcn_s_sleep(1); \
    if ((++_sp & 255u) == 0u) { if (xb_ld(&(bar)[XB_TMO])) break; if (_sp > XB_SPIN_CAP) { atomicAdd(&(bar)[XB_TMO], 1u); break; } } } } while (0)

struct XcdBarrier {
    unsigned* bar; unsigned x;
    volatile LAS unsigned* st;
};

__device__ __forceinline__ XcdBarrier xcd_barrier_post(unsigned* bar, volatile LAS unsigned* st) {
    XcdBarrier b; b.bar = bar; b.x = xb_xcc_id(); b.st = st;
    if (threadIdx.x == 0) (void)xb_add(&bar[XB_XCNT(b.x)], 1u);
    return b;
}
__device__ __forceinline__ void xcd_barrier_complete(unsigned* bar, unsigned x, unsigned& nloc, unsigned& nx) {
    const unsigned G = gridDim.x * gridDim.y * gridDim.z;
    unsigned sum, cnt, mine, sp = 0u;
    for (;;) {
        sum = 0u; cnt = 0u; mine = 0u;
#pragma unroll
        for (unsigned j = 0; j < 16; ++j) { const unsigned c = xb_ld(&bar[XB_XCNT(j)]); sum += c; cnt += (c > 0u) ? 1u : 0u; mine = (j == x) ? c : mine; }
        if (sum == G) break;
        __builtin_amdgcn_s_sleep(1);
        if ((++sp & 255u) == 0u) { if (xb_ld(&bar[XB_TMO])) break; if (sp > XB_SPIN_CAP) { atomicAdd(&bar[XB_TMO], 1u); break; } }
    }
    nloc = mine > 0u ? mine : 1u; nx = cnt > 0u ? cnt : 1u;
}

__device__ __forceinline__ void xcd_barrier(const XcdBarrier& b) {
    asm volatile("s_waitcnt vmcnt(0)" ::: "memory");
    __syncthreads();
    if (threadIdx.x == 0) {
        unsigned* bar = b.bar;
        __builtin_amdgcn_s_waitcnt(0);
        unsigned nloc = b.st[0], nx = b.st[1];
        if (nloc == 0u) { xcd_barrier_complete(bar, b.x, nloc, nx); b.st[0] = nloc; b.st[1] = nx; }
        const unsigned old = xb_add(&bar[XB_XSUB(b.x)], 1u);
        const unsigned gen = old / nloc;
        if (old + 1u == (gen + 1u) * nloc) {
            __builtin_amdgcn_fence(__ATOMIC_RELEASE, "agent");
            asm volatile("s_waitcnt vmcnt(0)" ::: "memory");
            const unsigned og = xb_add(&bar[XB_TOP], 1u);
            const unsigned tg = og / nx;
            if (og + 1u == (tg + 1u) * nx) xb_add(&bar[XB_TOPGEN], 1u);
            else XB_SPIN(xb_ld(&bar[XB_TOPGEN]) == tg, bar);
            __builtin_amdgcn_fence(__ATOMIC_ACQUIRE, "agent");
            xb_add(&bar[XB_XGEN(b.x)], 1u);
            asm volatile("s_waitcnt vmcnt(0)" ::: "memory");
        } else {
            XB_SPIN(xb_ld(&bar[XB_XGEN(b.x)]) == gen, bar);
            __builtin_amdgcn_fence(__ATOMIC_ACQUIRE, "agent");
            asm volatile("s_waitcnt vmcnt(0)" ::: "memory");
        }
    }
    __syncthreads();
}


#define PH(...) { const Params& P = kparams(); __VA_ARGS__ } xcd_barrier(xb);

template <int L>
__device__ __forceinline__ void run_layer(const XcdBarrier& xb, unsigned char* smem, LAS unsigned char* lds) {
  PH( EpiGU E{P.ssqB, P.act}; run_gemm(lds, P.hbB, L ? P.w_gu_a1 : P.w_gu_a0, 2 * DFF, DM, E); )
  PH( EpiRes<false, false> E{nullptr, P.hbB, P.hbA, P.ssqA, 0.5f, nullptr, nullptr}; run_gemm(lds, P.act, L ? P.w_d_a1 : P.w_d_a0, DM, DFF, E); )
  if (L == 0) {
    PH( EpiInEven E{0}; run_gemm(lds, P.hbA, P.w_evin, N_EVIN, DM, E); )
    PH( { EpiUQ E{P.ssq_cq, P.rope, P.Qb}; run_gemm(lds, P.cqb, P.w_uq, 768, 256, E); }
        { EpiUKV E{P.ssq_ckv, P.Kn, P.Vtb}; run_gemm(lds, P.ckvb, P.w_ukv, 1024, 256, E); } )
    PH( phase_attn_even(P, smem); )
  } else {
    PH( EpiInOdd E{0}; run_gemm(lds, P.hbA, P.w_odin, N_ODIN, DM, E); )
    PH( phase_scan(P); )
    PH( phase_attn_odd(P, smem); )
  }
  PH( EpiRes<false, false> E{nullptr, P.hbA, P.hbA, P.ssqA, 1.0f, nullptr, nullptr}; run_gemm(lds, L ? P.Qc : P.mix, L ? P.w_odout : P.w_evout, DM, DM, E); )
  PH( EpiGU E{P.ssqA, P.act}; run_gemm(lds, P.hbA, L ? P.w_gu_b1 : P.w_gu_b0, 2 * DFF, DM, E); )
  PH( EpiRes<false, false> E{nullptr, P.hbA, P.hbA, P.ssqA, 0.5f, nullptr, nullptr}; run_gemm(lds, P.act, L ? P.w_d_b1 : P.w_d_b0, DM, DFF, E); )
  PH( { EpiBf16Plain E{P.projb, DM}; run_gemm(lds, P.pb + (size_t)L * NTOK * 256, L ? P.w_pp1 : P.w_pp0, DM, 256, E); }
      { EpiRes<true, false> E{nullptr, P.hbA, P.hbB, P.ssqB, 0.f, P.ssqA, P.projb}; run_gemm(lds, P.hbA, L ? P.w_pg1 : P.w_pg0, DM, DM, E); } )
}

__global__ void __launch_bounds__(NTHREADS, 2) k_mega(Params Pdummy) {
  extern __shared__ __attribute__((aligned(16))) unsigned char lds_dyn[];
  unsigned char* smem = lds_dyn;
  LAS unsigned char* lds = (LAS unsigned char*)lds_dyn;
  cg::grid_group grid = cg::this_grid();
  if (threadIdx.x < 4) ((LAS unsigned*)(lds + 131072))[threadIdx.x] = 0u;
  __syncthreads();
  unsigned* barw; { const Params& P = kparams(); barw = P.barw; }
  const XcdBarrier xb = xcd_barrier_post(barw, (volatile LAS unsigned*)(lds + 131072));
  { const Params& P = kparams(); phase_prologue(P, smem); }
  grid.sync();
  run_layer<0>(xb, smem, lds);
  run_layer<1>(xb, smem, lds);
  { const Params& P = kparams(); phase_final(P); }
}

extern "C" void kernel_launch(void* const* d_in, const int* in_sizes, int n_in, void* d_out, int out_size, void* d_ws, size_t ws_size,
                              hipStream_t stream) {
  Params P{};
  const float** pf = (const float**)&P.x;
  for (int i = 0; i < 23; ++i) pf[i] = (const float*)d_in[i];
  P.out = (float*)d_out;
  unsigned char* ws = (unsigned char*)d_ws;
  size_t off = 0;
  auto take = [&](size_t bytes) { unsigned char* p = ws + off; off += (bytes + 255) & ~(size_t)255; return p; };
  const size_t MiB = 1024 * 1024;
  unsigned char* R1 = take(272 * MiB);
  P.act = (bf16_t*)R1;
  P.projb = (bf16_t*)R1;
  P.hbB = (bf16_t*)(R1 + 192 * MiB);
  {
    size_t o = 0;
    auto sub = [&](size_t bytes) { unsigned char* p = R1 + o; o += (bytes + 255) & ~(size_t)255; return p; };
    P.Qa = (bf16_t*)sub((size_t)NTOK * 512 * 2); P.Qb = (bf16_t*)sub((size_t)NTOK * 768 * 2);
    P.Ka = (bf16_t*)sub((size_t)NTOK * 128 * 2); P.Kn = (bf16_t*)sub((size_t)NTOK * 512 * 2); P.Kr = (bf16_t*)sub((size_t)NTOK * 32 * 2);
    P.Vta = (bf16_t*)sub((size_t)NTOK * 128 * 2); P.Vtb = (bf16_t*)sub((size_t)NTOK * 512 * 2);
    P.mix = (bf16_t*)sub((size_t)NTOK * 1024 * 2); P.cqb = (bf16_t*)sub((size_t)NTOK * 256 * 2); P.ckvb = (bf16_t*)sub((size_t)NTOK * 256 * 2);
    o = 0;
    P.Qc = (bf16_t*)sub((size_t)NTOK * 1024 * 2); P.Kc = (bf16_t*)sub((size_t)NTOK * 1024 * 2); P.Vtc = (bf16_t*)sub((size_t)NTOK * 1024 * 2);
  }
  P.hbA = (bf16_t*)take((size_t)NTOK * DM * 2);
  P.pb = (bf16_t*)take((size_t)2 * NTOK * 256 * 2);
  P.ssqA = (float*)take((size_t)NTOK * 16 * 4); P.ssqB = (float*)take((size_t)NTOK * 16 * 4);
  P.ssq_cq = (float*)take((size_t)NTOK * 4 * 4); P.ssq_ckv = (float*)take((size_t)NTOK * 4 * 4);
  P.logf = (float*)take((size_t)NTOK * 16 * 4); P.logc = (float*)take((size_t)NTOK * 16 * 4);
  P.rope = (float*)take((size_t)SEQ * 32 * 4);
  P.barw = (unsigned*)take((size_t)XCD_BAR_WORDS * 4);
  const size_t GU = (size_t)2 * DFF * DM * 2, DW = (size_t)DM * DFF * 2, SQ = (size_t)DM * DM * 2;
  P.w_gu_a0 = (bf16_t*)take(GU); P.w_gu_a1 = (bf16_t*)take(GU); P.w_gu_b0 = (bf16_t*)take(GU); P.w_gu_b1 = (bf16_t*)take(GU);
  P.w_d_a0 = (bf16_t*)take(DW); P.w_d_a1 = (bf16_t*)take(DW); P.w_d_b0 = (bf16_t*)take(DW); P.w_d_b1 = (bf16_t*)take(DW);
  P.w_pg0 = (bf16_t*)take(SQ); P.w_pg1 = (bf16_t*)take(SQ); P.w_pp0 = (bf16_t*)take((size_t)DM * 256 * 2); P.w_pp1 = (bf16_t*)take((size_t)DM * 256 * 2);
  P.w_evin = (bf16_t*)take((size_t)N_EVIN * DM * 2); P.w_uq = (bf16_t*)take((size_t)768 * 256 * 2); P.w_ukv = (bf16_t*)take((size_t)1024 * 256 * 2);
  P.w_evout = (bf16_t*)take(SQ); P.w_odin = (bf16_t*)take((size_t)N_ODIN * DM * 2); P.w_odout = (bf16_t*)take(SQ);
  if (off > ws_size) { fprintf(stderr, "workspace too small: need %zu have %zu\n", off, ws_size); return; }
  static int grid_blocks = 0;
  if (!grid_blocks) {
    int dev = 0, cus = 0, per_cu = 0;
    hipGetDevice(&dev);
    hipDeviceGetAttribute(&cus, hipDeviceAttributeMultiprocessorCount, dev);
    if (hipFuncSetAttribute((const void*)k_mega, hipFuncAttributeMaxDynamicSharedMemorySize, LDS_BYTES) != hipSuccess)
      fprintf(stderr, "hipFuncSetAttribute(MaxDynamicSharedMemorySize) failed\n");
    hipOccupancyMaxActiveBlocksPerMultiprocessor(&per_cu, k_mega, NTHREADS, LDS_BYTES);
    if (per_cu < 1) fprintf(stderr, "occupancy query says %d blocks/CU\n", per_cu);
    grid_blocks = cus & ~7;
    (void)hipGetLastError();
  }
  if (hipMemsetAsync(P.barw, 0, (size_t)XCD_BAR_WORDS * 4, stream) != hipSuccess) { fprintf(stderr, "memset of barrier words failed\n"); return; }
  void* args[] = {&P};
  hipError_t e = hipLaunchCooperativeKernel((void*)k_mega, dim3(grid_blocks), dim3(NTHREADS), args, LDS_BYTES, stream);
  if (e != hipSuccess) fprintf(stderr, "cooperative launch failed: %s (grid %d)\n", hipGetErrorString(e), grid_blocks);
}
```
